# Optimizing an MI355X kernel written in HIP

```python
import jax, jax.numpy as jnp
from jax import lax
import numpy as np

D_MODEL = 1024
BATCH = 32
SEQ = 2048
DEPTH = 2

N_MIXERS = 2
CONV_K = 4
EPS = 1e-6
M_INNER = 2 * D_MODEL
M_HEADS = 4
M_DV = M_INNER // M_HEADS
M_DK = M_DV // 2
M_CHUNK = 64
R_WIDTH = 3 * D_MODEL // 2
R_BLOCKS = 8
R_BS = R_WIDTH // R_BLOCKS
LRU_C = 8.0

N_A = (DEPTH + 1) // 2
N_B = DEPTH // 2

kernel_name = "hybrid_mlstm_rglru_trunk"


def rmsnorm(x, g):
    xf = x.astype(jnp.float32)
    y = xf * lax.rsqrt(jnp.mean(xf * xf, axis=-1, keepdims=True) + EPS)
    return (y * g.astype(jnp.float32)).astype(x.dtype)


def causal_dwconv(x, w, b):
    s = x.shape[1]
    xp = jnp.pad(x, ((0, 0), (CONV_K - 1, 0), (0, 0)))
    y = b + xp[:, 0:s] * w[0]
    for j in range(1, CONV_K):
        y = y + xp[:, j:j + s] * w[j]
    return y


def mlstm_chunkwise(q, k, v, log_i, log_f):
    b, h, s, dk = q.shape
    dv = v.shape[-1]
    L = M_CHUNK
    nc = s // L

    def to_chunks(t):
        t = t.reshape((b, h, nc, L) + t.shape[3:])
        return jnp.moveaxis(t, 2, 0)

    qc, kc, vc, ic, fc = (to_chunks(t) for t in (q, k, v, log_i, log_f))
    causal = jnp.tril(jnp.ones((L, L), dtype=bool))

    def step(carry, inp):
        C, n, m = carry
        qb, kb, vb, ib, fb = inp
        F = jnp.cumsum(fb, axis=-1)
        D = F[..., :, None] - F[..., None, :] + ib[..., None, :]
        D = jnp.where(causal, D, -jnp.inf)
        m_t = jnp.maximum(F + m[..., None], jnp.max(D, axis=-1))
        decay = jnp.exp(F + m[..., None] - m_t)
        W = jnp.exp(D - m_t[..., None])
        Sm = jnp.einsum('bhtk,bhsk->bhts', qb, kb) * W
        num = (decay[..., None] * jnp.einsum('bhtk,bhkv->bhtv', qb, C)
               + jnp.einsum('bhts,bhsv->bhtv', Sm, vb))
        den = decay * jnp.einsum('bhtk,bhk->bht', qb, n) + jnp.sum(Sm, axis=-1)
        hb = num / jnp.maximum(jnp.abs(den), jnp.exp(-m_t))[..., None]
        w_last = W[..., -1, :]
        d_last = decay[..., -1]
        C_new = d_last[..., None, None] * C + jnp.einsum('bhs,bhsk,bhsv->bhkv', w_last, kb, vb)
        n_new = d_last[..., None] * n + jnp.einsum('bhs,bhsk->bhk', w_last, kb)
        return (C_new, n_new, m_t[..., -1]), hb

    init = (jnp.zeros((b, h, dk, dv), jnp.float32),
            jnp.zeros((b, h, dk), jnp.float32),
            jnp.zeros((b, h), jnp.float32))
    _, hs = lax.scan(step, init, (qc, kc, vc, ic, fc))
    return jnp.moveaxis(hs, 0, 2).reshape(b, h, s, dv)


def mlstm_mixer(u, w_in, conv_w, conv_b, w_q, w_k, w_v, b_i, b_f, norm_w, skip, w_out):
    bsz, s, _ = u.shape
    proj = u @ w_in
    xm, z, o_pre, i_pre, f_pre = jnp.split(
        proj, [M_INNER, 2 * M_INNER, 3 * M_INNER, 3 * M_INNER + M_HEADS], axis=-1)
    xc = jax.nn.silu(causal_dwconv(xm, conv_w, conv_b))
    xch = xc.reshape(bsz, s, M_HEADS, M_DV)
    xmh = xm.reshape(bsz, s, M_HEADS, M_DV)
    q = jnp.einsum('bshd,hde->bhse', xch, w_q).astype(jnp.float32) * (M_DK ** -0.5)
    k = jnp.einsum('bshd,hde->bhse', xch, w_k).astype(jnp.float32)
    v = jnp.einsum('bshd,hde->bhse', xmh, w_v).astype(jnp.float32)
    log_i = jnp.transpose((i_pre + b_i).astype(jnp.float32), (0, 2, 1))
    log_f = jnp.transpose(jax.nn.log_sigmoid((f_pre + b_f).astype(jnp.float32)), (0, 2, 1))
    h_tilde = jnp.transpose(mlstm_chunkwise(q, k, v, log_i, log_f), (0, 2, 1, 3))
    o = jax.nn.sigmoid(o_pre.astype(jnp.float32)).reshape(bsz, s, M_HEADS, M_DV)
    hh = o * h_tilde
    mu = jnp.mean(hh, axis=-1, keepdims=True)
    var = jnp.mean(jnp.square(hh - mu), axis=-1, keepdims=True)
    hn = ((hh - mu) * lax.rsqrt(var + EPS)).reshape(bsz, s, M_INNER)
    hn = (hn * norm_w.astype(jnp.float32)).astype(u.dtype)
    y = (hn + skip * xc) * jax.nn.silu(z)
    return y @ w_out


def linear_scan(a, bt):
    def step(hc, ab):
        a_t, b_t = ab
        hc = a_t * hc + b_t
        return hc, hc
    h0 = jnp.zeros((a.shape[0], a.shape[2]), jnp.float32)
    _, hs = lax.scan(step, h0, (jnp.moveaxis(a, 1, 0), jnp.moveaxis(bt, 1, 0)))
    return jnp.moveaxis(hs, 0, 1)


def rglru_mixer(u, w_in, conv_w, conv_b, w_a, b_a, w_x, b_x, lam, w_out):
    bsz, s, _ = u.shape
    proj = u @ w_in
    xr, g = jnp.split(proj, [R_WIDTH], axis=-1)
    xc = causal_dwconv(xr, conv_w, conv_b)
    xb = xc.reshape(bsz, s, R_BLOCKS, R_BS)
    r = jax.nn.sigmoid(jnp.einsum('bsnc,ncd->bsnd', xb, w_a).reshape(bsz, s, R_WIDTH) + b_a)
    ig = jax.nn.sigmoid(jnp.einsum('bsnc,ncd->bsnd', xb, w_x).reshape(bsz, s, R_WIDTH) + b_x)
    log_a = -LRU_C * r.astype(jnp.float32) * jax.nn.softplus(-lam.astype(jnp.float32))
    a = jnp.exp(log_a)
    bt = jnp.sqrt(-jnp.expm1(2.0 * log_a)) * (ig * xc).astype(jnp.float32)
    hs = linear_scan(a, bt).astype(u.dtype)
    y = hs * jax.nn.silu(g)
    return y @ w_out


def setup_inputs(seed: int = 0) -> dict:
    key = jax.random.key(seed)
    ks = iter(jax.random.split(key, 32))
    nrm = lambda shape, scale: jax.random.normal(next(ks), shape, jnp.float32) * scale
    i_w = 3 * M_INNER + 2 * M_HEADS
    lam_u = jax.random.uniform(next(ks), (N_B, R_WIDTH), jnp.float32, 0.9, 0.999)
    sig = lam_u ** (1.0 / LRU_C)
    b_f = jnp.broadcast_to(jnp.linspace(3.0, 6.0, M_HEADS, dtype=jnp.float32), (N_A, M_HEADS))
    return {
        "x": nrm((BATCH, SEQ, D_MODEL), 1.0),
        "ln_g": 1.0 + nrm((DEPTH, D_MODEL), 0.05),
        "final_g": 1.0 + nrm((D_MODEL,), 0.05),
        "m_w_in": nrm((N_A, D_MODEL, i_w), D_MODEL ** -0.5),
        "m_conv_w": nrm((N_A, CONV_K, M_INNER), CONV_K ** -0.5),
        "m_conv_b": nrm((N_A, M_INNER), 0.02),
        "m_w_q": nrm((N_A, M_HEADS, M_DV, M_DK), M_DV ** -0.5),
        "m_w_k": nrm((N_A, M_HEADS, M_DV, M_DK), M_DV ** -0.5),
        "m_w_v": nrm((N_A, M_HEADS, M_DV, M_DV), M_DV ** -0.5),
        "m_b_i": nrm((N_A, M_HEADS), 0.1),
        "m_b_f": b_f + nrm((N_A, M_HEADS), 0.1),
        "m_norm_w": 1.0 + nrm((N_A, M_INNER), 0.05),
        "m_skip": 1.0 + nrm((N_A, M_INNER), 0.05),
        "m_w_out": nrm((N_A, M_INNER, D_MODEL), M_INNER ** -0.5),
        "r_w_in": nrm((N_B, D_MODEL, 2 * R_WIDTH), D_MODEL ** -0.5),
        "r_conv_w": nrm((N_B, CONV_K, R_WIDTH), CONV_K ** -0.5),
        "r_conv_b": nrm((N_B, R_WIDTH), 0.02),
        "r_w_a": nrm((N_B, R_BLOCKS, R_BS, R_BS), R_BS ** -0.5),
        "r_b_a": nrm((N_B, R_WIDTH), 0.02),
        "r_w_x": nrm((N_B, R_BLOCKS, R_BS, R_BS), R_BS ** -0.5),
        "r_b_x": nrm((N_B, R_WIDTH), 0.02),
        "r_lam": jnp.log(sig / (1.0 - sig)),
        "r_w_out": nrm((N_B, R_WIDTH, D_MODEL), R_WIDTH ** -0.5),
    }


def reference(x, ln_g, final_g, m_w_in, m_conv_w, m_conv_b, m_w_q, m_w_k, m_w_v, m_b_i, m_b_f,
              m_norm_w, m_skip, m_w_out, r_w_in, r_conv_w, r_conv_b, r_w_a, r_b_a, r_w_x, r_b_x,
              r_lam, r_w_out):
    for layer in range(DEPTH):
        u = rmsnorm(x, ln_g[layer])
        j = layer // N_MIXERS
        if layer % N_MIXERS == 0:
            y = mlstm_mixer(u, m_w_in[j], m_conv_w[j], m_conv_b[j], m_w_q[j], m_w_k[j], m_w_v[j],
                            m_b_i[j], m_b_f[j], m_norm_w[j], m_skip[j], m_w_out[j])
        else:
            y = rglru_mixer(u, r_w_in[j], r_conv_w[j], r_conv_b[j], r_w_a[j], r_b_a[j],
                            r_w_x[j], r_b_x[j], r_lam[j], r_w_out[j])
        x = x + y
    return rmsnorm(x, final_g)
```

```cpp
#include <hip/hip_runtime.h>
#include <hip/hip_cooperative_groups.h>
#include <cstdio>
namespace cg = cooperative_groups;

#define DI __device__ __forceinline__
#define LAS __attribute__((address_space(3)))
typedef unsigned short bf16_t;
typedef short bf16x8 __attribute__((ext_vector_type(8)));
typedef short s16x4 __attribute__((ext_vector_type(4)));
typedef float f32x2 __attribute__((ext_vector_type(2)));
typedef float f32x4 __attribute__((ext_vector_type(4)));
typedef float f32x16 __attribute__((ext_vector_type(16)));
typedef unsigned u32x2 __attribute__((ext_vector_type(2)));
typedef unsigned u32x4 __attribute__((ext_vector_type(4)));
typedef __bf16 bf2_t __attribute__((ext_vector_type(2)));

constexpr int T_ = 65536, S_ = 2048;
constexpr float EPS_ = 1e-6f;
constexpr size_t MB_ = 1u << 20;
constexpr size_t WS_WT_XM = 0, WS_WT_ZO = 4 * MB_, WS_WT_QK = 12 * MB_, WS_WT_V = 14 * MB_, WS_WT_OUT0 = 16 * MB_, WS_WT_IN1 = 20 * MB_,
                 WS_WT_G = 26 * MB_, WS_WT_OUT1 = 28 * MB_, WS_LI = 31 * MB_, WS_LF = 32 * MB_, WS_GP = 33 * MB_, WS_GQ = 34 * MB_, WS_GD = 35 * MB_,
                 WS_GF = 36 * MB_, WS_GW = 37 * MB_, WS_SS = 38 * MB_, WS_U = 40 * MB_, WS_RA = 168 * MB_, WS_RB = 424 * MB_, WS_RC = 680 * MB_,
                 WS_LA = 40 * MB_, WS_BT = 232 * MB_, WS_SP = 39 * MB_, WS_SS1 = 38 * MB_ + 512 * 1024, WS_BAR = 39 * MB_ + 65536;
constexpr int LDS_BYTES = 140288;

struct Params { const float* in[23]; float* out; unsigned char* ws; unsigned rep_mask; unsigned pad; };
#ifndef REP_MASK
#define REP_MASK 0u
#endif
#ifndef PH_MASK
#define PH_MASK 0xffffu
#endif
#define PH_BEGIN(k) for (int r_ = 0, n_ = ((PH_MASK >> (k)) & 1u) ? 1 + (int)((p.rep_mask >> (k)) & 1u) : 0; r_ < n_; ++r_) {
#define PH_END xcd_barrier(xb); }
#define PH_END_CG grid.sync(); }

DI unsigned pk2(float a, float b) { f32x2 v = {a, b}; bf2_t r = __builtin_convertvector(v, bf2_t); return __builtin_bit_cast(unsigned, r); }
DI int opq(int x) { asm volatile("" : "+v"(x)); return x; }
DI float bflo(unsigned u) { return __uint_as_float(u << 16); }
DI float bfhi(unsigned u) { return __uint_as_float(u & 0xffff0000u); }
DI float sigm(float x) { return __builtin_amdgcn_rcpf(1.f + __expf(-x)); }
DI float silu_(float x) { return x * __builtin_amdgcn_rcpf(1.f + __expf(-x)); }
DI float wave_sum(float v) {
    v += __int_as_float(__builtin_amdgcn_update_dpp(0, __float_as_int(v), 0xB1, 0xf, 0xf, true));
    v += __int_as_float(__builtin_amdgcn_update_dpp(0, __float_as_int(v), 0x4E, 0xf, 0xf, true));
    v += __int_as_float(__builtin_amdgcn_update_dpp(0, __float_as_int(v), 0x141, 0xf, 0xf, true));
    v += __int_as_float(__builtin_amdgcn_update_dpp(0, __float_as_int(v), 0x140, 0xf, 0xf, true));
    const int vi = __float_as_int(v);
    return (__int_as_float(__builtin_amdgcn_readlane(vi, 0)) + __int_as_float(__builtin_amdgcn_readlane(vi, 16))) +
           (__int_as_float(__builtin_amdgcn_readlane(vi, 32)) + __int_as_float(__builtin_amdgcn_readlane(vi, 48)));
}
DI void unpack8(const u32x4& u, float (&f)[8]) {
#pragma unroll
    for (int i = 0; i < 4; ++i) { f[2 * i] = bflo(u[i]); f[2 * i + 1] = bfhi(u[i]); }
}
DI u32x4 pack8f(const float (&f)[8]) { u32x4 r; r[0] = pk2(f[0], f[1]); r[1] = pk2(f[2], f[3]); r[2] = pk2(f[4], f[5]); r[3] = pk2(f[6], f[7]); return r; }

constexpr int BM = 256, BK = 64, HALF = 128, HTB = HALF * BK * 2, NXCD = 8, WGM = 8;
DI int lds_byte(int r, int c) { const int st = (r >> 4) * 2 + (c >> 5), rr = r & 15, cc = c & 31, ob = rr * 64 + cc * 2; return st * 1024 + (ob ^ (((ob >> 9) & 1) << 5)); }
DI void stage_rc(int b, int& R, int& C) { const int st = b / 1024, sb = b % 1024, swz = sb ^ (((sb >> 9) & 1) << 5); R = (st >> 1) * 16 + swz / 64; C = (st & 1) * 32 + (swz % 64) / 2; }
DI int perm32(int rho) { const int n = rho >> 4, i = rho & 15; return 8 * (i >> 2) + 4 * n + (i & 3); }

DI bool unit_next(int i, int nM, int nN, int vb, int& pm, int& pn) {
    const int nwg = nM * nN; const long L = (long)i * gridDim.x + vb; if (L >= nwg) return false;
    int wgid = (int)L; { const int q = nwg / NXCD, r = nwg % NXCD, xcd = wgid % NXCD, off = wgid / NXCD; wgid = (xcd < r ? xcd * (q + 1) : r * (q + 1) + (xcd - r) * q) + off; }
    const int nig = WGM * nN, gid = wgid / nig, fm = gid * WGM, gsz = (nM - fm) < WGM ? (nM - fm) : WGM;
    pm = fm + ((wgid % nig) % gsz); pn = (wgid % nig) / gsz; return true;
}

template <bool PERM, class Dec, class Epi>
DI void gemm_phase(LAS unsigned char* lds, const int nM, const int nN, const int K, const int lda, const int ldb, const Dec& dec, const Epi& epi, const int vb, const int panel = -1) {
    const int tid = opq(threadIdx.x), wid = __builtin_amdgcn_readfirstlane(tid >> 6), lane = tid & 63, wr = wid >> 2, wc = wid & 3, fr = lane & 15, fq = lane >> 4;
    const int nt = K / BK;
    unsigned voffA[2], voffB[2];
#pragma unroll
    for (int i = 0; i < 2; ++i) { int R, C; stage_rc(tid * 16 + i * 8192, R, C); const int Rb = PERM ? ((R & ~31) + perm32(R & 31)) : R;
        voffA[i] = (unsigned)(R * lda + C) * 2u; voffB[i] = (unsigned)(Rb * ldb + C) * 2u; }
    const size_t kstep = (size_t)(BK * 2);
    const size_t hstepA = (size_t)HALF * lda * 2, hstepB = (size_t)HALF * ldb * 2;
    const unsigned ldsw = (unsigned)wid * 1024u;
    const int aoff = lds_byte(wr * 64 + fr, fq * 8), boff = lds_byte(wc * 32 + fr, fq * 8);
#define G_SA(b, h) (((b) * 2 + (h)) * HTB)
#define G_SB(b, h) ((4 + (b) * 2 + (h)) * HTB)
#define G_STAGE(bufoff, gbase, voff) do { _Pragma("unroll") for (int _i = 0; _i < 2; ++_i) \
        __builtin_amdgcn_global_load_lds((const unsigned*)((const char*)(gbase) + (voff)[_i]), (LAS unsigned*)(lds + (bufoff) + ldsw + _i * 8192), 16, 0, 0); } while (0)
#define G_LDA(dst, b, h) do { _Pragma("unroll") for (int m = 0; m < 4; ++m) _Pragma("unroll") for (int k = 0; k < 2; ++k) dst[m][k] = *(const LAS bf16x8*)(lds + G_SA(b, h) + aoff + m * 2048 + k * 1024); } while (0)
#define G_LDB(dst, b, h) do { _Pragma("unroll") for (int n = 0; n < 2; ++n) _Pragma("unroll") for (int k = 0; k < 2; ++k) dst[n][k] = *(const LAS bf16x8*)(lds + G_SB(b, h) + boff + n * 2048 + k * 1024); } while (0)
#define G_MMA(ai, bj, At, Bt) do { __builtin_amdgcn_s_setprio(1); _Pragma("unroll") for (int m = 0; m < 4; ++m) _Pragma("unroll") for (int n = 0; n < 2; ++n) _Pragma("unroll") for (int k = 0; k < 2; ++k) \
        acc[ai][bj][m][n] = __builtin_amdgcn_mfma_f32_16x16x32_bf16(Bt[n][k], At[m][k], acc[ai][bj][m][n], 0, 0, 0); __builtin_amdgcn_s_setprio(0); } while (0)
#define G_WAIT_V(n) asm volatile("s_waitcnt vmcnt(" #n ")" ::: "memory")
#define G_WAIT_L(n) asm volatile("s_waitcnt lgkmcnt(" #n ")" ::: "memory")
#define G_BAR __builtin_amdgcn_s_barrier()
#define G_SCHED __builtin_amdgcn_sched_barrier(0)
    int cpm, cpn, npm, npn, ui = 0;
    if (panel >= 0) { cpm = panel; cpn = 0; } else if (!unit_next(0, nM, nN, vb, cpm, cpn)) return;
    f32x4 acc[2][2][4][2];
#pragma unroll
    for (int a = 0; a < 2; ++a)
#pragma unroll
        for (int b = 0; b < 2; ++b)
#pragma unroll
            for (int m = 0; m < 4; ++m)
#pragma unroll
                for (int n = 0; n < 2; ++n) acc[a][b][m][n] = (f32x4){0.f, 0.f, 0.f, 0.f};
    bf16x8 At[4][2], B0[2][2], B1[2][2];
    const char* cA; const char* cB; dec(cpm, cpn, cA, cB);
    G_STAGE(G_SB(0, 0), cB, voffB); G_STAGE(G_SA(0, 0), cA, voffA); G_STAGE(G_SB(0, 1), cB + hstepB, voffB); G_STAGE(G_SA(0, 1), cA + hstepA, voffA);
    if (wr == 1) G_BAR;
    G_WAIT_V(4); G_BAR;
    G_STAGE(G_SB(1, 0), cB + kstep, voffB); G_STAGE(G_SA(1, 0), cA + kstep, voffA); G_STAGE(G_SB(1, 1), cB + hstepB + kstep, voffB);
    G_WAIT_V(6); G_BAR;
    for (;;) {
        bool has_next;
        if (panel >= 0) { has_next = (ui + 1 < nN); npm = panel; npn = ui + 1; } else has_next = unit_next(ui + 1, nM, nN, vb, npm, npn);
        const char* nA = cA; const char* nB = cB; if (has_next) dec(npm, npn, nA, nB);
#pragma nounroll
        for (int t = 0; t < nt; t += 2) {
            const bool last = (t == nt - 2);
            const char* a1 = cA + (size_t)(t + 1) * kstep;
            const char* a2 = last ? nA : cA + (size_t)(t + 2) * kstep; const char* b2 = last ? nB : cB + (size_t)(t + 2) * kstep;
            const char* a3 = a2 + kstep; const char* b3 = b2 + kstep;
            G_LDB(B0, 0, 0); G_SCHED; G_LDA(At, 0, 0); G_STAGE(G_SA(1, 1), a1 + hstepA, voffA);
            G_WAIT_L(8); G_BAR; G_WAIT_L(0); G_MMA(0, 0, At, B0); G_BAR; G_SCHED;
            G_LDB(B1, 0, 1); G_STAGE(G_SB(0, 0), b2, voffB);
            G_BAR; G_WAIT_L(0); G_MMA(0, 1, At, B1); G_BAR;
            G_LDA(At, 0, 1); G_STAGE(G_SA(0, 0), a2, voffA);
            G_BAR; G_WAIT_L(0); G_MMA(1, 0, At, B0); G_BAR; G_SCHED;
            G_STAGE(G_SB(0, 1), b2 + hstepB, voffB);
            G_WAIT_V(6); G_BAR; G_MMA(1, 1, At, B1); G_BAR;
            G_LDB(B0, 1, 0); G_SCHED; G_LDA(At, 1, 0); G_STAGE(G_SA(0, 1), a2 + hstepA, voffA);
            G_WAIT_L(8); G_BAR; G_WAIT_L(0); G_MMA(0, 0, At, B0); G_BAR; G_SCHED;
            G_LDB(B1, 1, 1); G_STAGE(G_SB(1, 0), b3, voffB);
            G_BAR; G_WAIT_L(0); G_MMA(0, 1, At, B1); G_BAR;
            G_LDA(At, 1, 1); G_STAGE(G_SA(1, 0), a3, voffA);
            G_BAR; G_WAIT_L(0); G_MMA(1, 0, At, B0); G_BAR; G_SCHED;
            G_STAGE(G_SB(1, 1), b3 + hstepB, voffB);
            G_WAIT_V(6); G_BAR; G_MMA(1, 1, At, B1); G_BAR;
        }
        epi(acc, cpm, cpn, wr, wc, fr, fq);
        if (!has_next) break;
#pragma unroll
        for (int a = 0; a < 2; ++a)
#pragma unroll
            for (int b = 0; b < 2; ++b)
#pragma unroll
                for (int m = 0; m < 4; ++m)
#pragma unroll
                    for (int n = 0; n < 2; ++n) acc[a][b][m][n] = (f32x4){0.f, 0.f, 0.f, 0.f};
        cpm = npm; cpn = npn; cA = nA; cB = nB; ++ui;
    }
    G_WAIT_V(0);
    if (wr == 0) G_BAR;
    G_BAR;
#undef G_SA
#undef G_SB
#undef G_STAGE
#undef G_LDA
#undef G_LDB
#undef G_MMA
#undef G_WAIT_V
#undef G_WAIT_L
#undef G_BAR
#undef G_SCHED
}

template <int ACT>
DI void epi_bf16(const f32x4 (&acc)[2][2][4][2], bf16_t* O, const int ldc, int wr, int wc, int fr, int fq, const float* ssrow = nullptr) {
#pragma unroll
    for (int ai = 0; ai < 2; ++ai)
#pragma unroll
        for (int m = 0; m < 4; ++m) {
            bf16_t* rowp = O + (size_t)(ai * HALF + wr * 64 + m * 16 + fr) * ldc + wc * 32 + 8 * fq;
            const float rsc = ssrow ? __builtin_amdgcn_rsqf(ssrow[ai * HALF + wr * 64 + m * 16 + fr] * (1.f / 1024.f) + EPS_) : 1.f;
#pragma unroll
            for (int bj = 0; bj < 2; ++bj) {
                f32x4 v0 = acc[ai][bj][m][0] * rsc, v1 = acc[ai][bj][m][1] * rsc;
                if (ACT == 1) {
#pragma unroll
                    for (int j = 0; j < 4; ++j) { v0[j] = silu_(v0[j]); v1[j] = silu_(v1[j]); } }
                if (ACT == 2) {
#pragma unroll
                    for (int j = 0; j < 4; ++j) { v0[j] = sigm(v0[j]); v1[j] = sigm(v1[j]); } }
                u32x4 w; w[0] = pk2(v0[0], v0[1]); w[1] = pk2(v0[2], v0[3]); w[2] = pk2(v1[0], v1[1]); w[3] = pk2(v1[2], v1[3]);
                *(u32x4*)(rowp + bj * HALF) = w;
            }
        }
}

struct TJob { const float* src; bf16_t* dst; int lds_, srcb, K, N, ldd, dstb; float scale; const float* ks; };
DI TJob get_job(const Params& p, int j) {
    TJob t; unsigned char* ws = p.ws;
    switch (j) {
    case 0: t = TJob{p.in[3], (bf16_t*)(ws + WS_WT_XM), 6152, 0, 1024, 2048, 1024, 0, 1.f, nullptr}; break;
    case 1: t = TJob{p.in[3] + 2048, (bf16_t*)(ws + WS_WT_ZO), 6152, 0, 1024, 4096, 1024, 0, 1.f, nullptr}; break;
    case 2: t = TJob{p.in[6], (bf16_t*)(ws + WS_WT_QK), 256, 512 * 256, 512, 256, 512, 512 * 512, 0.0625f, nullptr}; break;
    case 3: t = TJob{p.in[7], (bf16_t*)(ws + WS_WT_QK) + 256 * 512, 256, 512 * 256, 512, 256, 512, 512 * 512, 1.f, nullptr}; break;
    case 4: t = TJob{p.in[8], (bf16_t*)(ws + WS_WT_V), 512, 512 * 512, 512, 512, 512, 512 * 512, 1.f, nullptr}; break;
    case 5: t = TJob{p.in[13], (bf16_t*)(ws + WS_WT_OUT0), 1024, 0, 2048, 1024, 2048, 0, 1.f, nullptr}; break;
    case 6: t = TJob{p.in[14], (bf16_t*)(ws + WS_WT_IN1), 3072, 0, 1024, 3072, 1024, 0, 1.f, p.in[1] + 1024}; break;
    default: t = TJob{p.in[22], (bf16_t*)(ws + WS_WT_OUT1), 1024, 0, 1536, 1024, 1536, 0, 1.f, nullptr}; break;
    }
    return t;
}

template <bool GATES>
DI void rmsnorm_rows(const float* X, const float* g, bf16_t* U, const float* Wg, const float* b_i, const float* b_f, float* LI, float* LF) {
    const int tid_ = opq(threadIdx.x), lane = tid_ & 63, wid = tid_ >> 6;
    const int gw = blockIdx.x * 8 + wid, nw = gridDim.x * 8;
    f32x4 g4[4];
#pragma unroll
    for (int i = 0; i < 4; ++i) g4[i] = ((const f32x4*)g)[lane + 64 * i];
    f32x4 nx[4];
#pragma unroll
    for (int i = 0; i < 4; ++i) nx[i] = ((const f32x4*)(X + (size_t)gw * 1024))[lane + 64 * i];
    for (int row = gw; row < T_; row += nw) {
        f32x4 v[4]; float ss = 0.f;
        const int rown = (row + nw < T_) ? row + nw : row;
#pragma unroll
        for (int i = 0; i < 4; ++i) { v[i] = nx[i]; nx[i] = ((const f32x4*)(X + (size_t)rown * 1024))[lane + 64 * i]; ss += v[i][0] * v[i][0] + v[i][1] * v[i][1] + v[i][2] * v[i][2] + v[i][3] * v[i][3]; }
        ss = wave_sum(ss);
        const float rs = __builtin_amdgcn_rsqf(ss * (1.f / 1024.f) + EPS_);
#pragma unroll
        for (int i = 0; i < 4; ++i) { v[i] = v[i] * rs * g4[i]; u32x2 w; w[0] = pk2(v[i][0], v[i][1]); w[1] = pk2(v[i][2], v[i][3]); ((u32x2*)(U + (size_t)row * 1024))[lane + 64 * i] = w; }
        if (GATES) {
            float d[8];
#pragma unroll
            for (int j = 0; j < 8; ++j) { float s = 0.f;
#pragma unroll
                for (int i = 0; i < 4; ++i) { const f32x4 w = ((const f32x4*)(Wg + j * 1024))[lane + 64 * i]; s += v[i][0] * w[0] + v[i][1] * w[1] + v[i][2] * w[2] + v[i][3] * w[3]; }
                d[j] = wave_sum(s); }
            float val = d[0];
#pragma unroll
            for (int j = 1; j < 8; ++j) val = (lane == j) ? d[j] : val;
            if (lane < 8) {
                const int b = row >> 11, s = row & 2047, hh = lane & 3;
                if (lane < 4) LI[(size_t)(b * 4 + hh) * S_ + s] = val + b_i[hh];
                else { const float xx = val + b_f[hh]; LF[(size_t)(b * 4 + hh) * S_ + s] = fminf(xx, 0.f) - log1pf(__expf(-fabsf(xx))); }
            }
        }
    }
}

DI void phase_prep(const Params& p, unsigned char* shm) {
    const int tid = opq(threadIdx.x);
    const size_t gtid = (size_t)blockIdx.x * 512 + tid, gsize = (size_t)gridDim.x * 512;
    float* tl = (float*)shm;
    float* Wg = (float*)(shm + 20480);
    for (int idx = tid; idx < 8192; idx += 512) { const int j = idx >> 10, k = idx & 1023; Wg[idx] = p.in[3][(size_t)k * 6152 + 6144 + j]; }
    for (int tile = blockIdx.x; tile < 3712; tile += gridDim.x) {
        int j, base;
        if (tile < 512) { j = 0; base = 0; } else if (tile < 1536) { j = 1; base = 512; } else if (tile < 1664) { j = 2; base = 1536; } else if (tile < 1792) { j = 3; base = 1664; }
        else if (tile < 2048) { j = 4; base = 1792; } else if (tile < 2560) { j = 5; base = 2048; } else if (tile < 3328) { j = 6; base = 2560; } else { j = 7; base = 3328; }
        const TJob jb = get_job(p, j);
        const int lt = tile - base, ntn = jb.N / 64, ntk = jb.K / 64;
        const int b = lt / (ntn * ntk), r = lt % (ntn * ntk), tk = r / ntn, tn = r % ntn;
        const float* src = jb.src + (size_t)b * jb.srcb + (size_t)(tk * 64) * jb.lds_ + tn * 64;
#pragma unroll
        for (int i = 0; i < 2; ++i) { const int kk = (tid >> 4) + 32 * i, c4 = (tid & 15) * 4; const f32x4 v = *(const f32x4*)(src + (size_t)kk * jb.lds_ + c4);
            const float sc = jb.ks ? jb.scale * jb.ks[tk * 64 + kk] : jb.scale;
            tl[kk * 65 + c4] = v[0] * sc; tl[kk * 65 + c4 + 1] = v[1] * sc; tl[kk * 65 + c4 + 2] = v[2] * sc; tl[kk * 65 + c4 + 3] = v[3] * sc; }
        __syncthreads();
        { const int n = tid >> 3, k8 = (tid & 7) * 8; float f[8];
#pragma unroll
          for (int e = 0; e < 8; ++e) f[e] = tl[(k8 + e) * 65 + n];
          *(u32x4*)(jb.dst + (size_t)b * jb.dstb + (size_t)(tn * 64 + n) * jb.ldd + tk * 64 + k8) = pack8f(f); }
        __syncthreads();
    }
    { bf16_t* WG = (bf16_t*)(p.ws + WS_WT_G);
      for (size_t idx = gtid; idx < (size_t)8 * 2 * 192 * 192; idx += gsize) {
          const int c = (int)(idx % 192), d = (int)((idx / 192) % 192), g = (int)((idx / 36864) & 1), blk = (int)(idx / 73728);
          const float v = (g ? p.in[19] : p.in[17])[(size_t)blk * 36864 + (size_t)c * 192 + d];
          WG[idx] = (bf16_t)(pk2(v, 0.f) & 0xffffu); } }
    { float* SS = (float*)(p.ws + WS_SS); float* SS1 = (float*)(p.ws + WS_SS1); for (size_t idx = gtid; idx < (size_t)T_; idx += gsize) { SS[idx] = 0.f; SS1[idx] = 0.f; } }
    { float* SP = (float*)(p.ws + WS_SP); for (size_t idx = gtid; idx < (size_t)1536; idx += gsize) SP[idx] = -8.f * log1pf(__expf(-p.in[21][idx])); }
    __syncthreads();
    rmsnorm_rows<true>(p.in[0], p.in[1], (bf16_t*)(p.ws + WS_U), Wg, p.in[9], p.in[10], (float*)(p.ws + WS_LI), (float*)(p.ws + WS_LF));
}

template <int CIN, int COUT, bool SILU>
DI void conv_phase(const bf16_t* X, const float* w, const float* bias, bf16_t* Y) {
    constexpr int NG = COUT / 8, NGV = CIN / 8;
    const int total = (T_ / 16) * NG;
    for (int it = blockIdx.x * 512 + opq(threadIdx.x); it < total; it += gridDim.x * 512) {
        const int cgp = it % NG, tc = it / NG, t0 = tc * 16;
        if (cgp >= NGV) {
            for (int r = 0; r < 16; ++r) *(u32x4*)(Y + (size_t)(t0 + r) * COUT + cgp * 8) = (u32x4){0u, 0u, 0u, 0u};
            continue;
        }
        const int c0 = cgp * 8;
        float w0[8], w1[8], w2[8], w3[8], bb[8], p3[8], p2[8], p1[8];
#pragma unroll
        for (int e = 0; e < 8; ++e) { w0[e] = w[c0 + e]; w1[e] = w[CIN + c0 + e]; w2[e] = w[2 * CIN + c0 + e]; w3[e] = w[3 * CIN + c0 + e]; bb[e] = bias[c0 + e]; }
        if ((t0 & 2047) == 0) {
#pragma unroll
            for (int e = 0; e < 8; ++e) { p3[e] = 0.f; p2[e] = 0.f; p1[e] = 0.f; }
        } else {
            unpack8(*(const u32x4*)(X + (size_t)(t0 - 3) * CIN + c0), p3);
            unpack8(*(const u32x4*)(X + (size_t)(t0 - 2) * CIN + c0), p2);
            unpack8(*(const u32x4*)(X + (size_t)(t0 - 1) * CIN + c0), p1);
        }
#pragma unroll
        for (int r = 0; r < 16; ++r) {
            float cur[8], y[8];
            unpack8(*(const u32x4*)(X + (size_t)(t0 + r) * CIN + c0), cur);
#pragma unroll
            for (int e = 0; e < 8; ++e) { float v = bb[e] + w0[e] * p3[e] + w1[e] * p2[e] + w2[e] * p1[e] + w3[e] * cur[e]; y[e] = SILU ? silu_(v) : v; p3[e] = p2[e]; p2[e] = p1[e]; p1[e] = cur[e]; }
            *(u32x4*)(Y + (size_t)(t0 + r) * COUT + c0) = pack8f(y);
        }
    }
}

DI void conv0_phase(const bf16_t* X, const float* w, const float* bias, bf16_t* Y) {
    const int gt = blockIdx.x * 512 + opq(threadIdx.x), stride = gridDim.x * 512;
    const int c0 = (gt & 255) * 8;
    float w0[8], w1[8], w2[8], w3[8], bb[8];
#pragma unroll
    for (int e = 0; e < 8; ++e) { w0[e] = w[c0 + e]; w1[e] = w[2048 + c0 + e]; w2[e] = w[4096 + c0 + e]; w3[e] = w[6144 + c0 + e]; bb[e] = bias[c0 + e]; }
    const int total = (T_ / 16) * 256;
    u32x4 nx[19];
    if (gt < total) {
        const int t0 = (gt >> 8) * 16; const bool first = (t0 & 2047) == 0;
#pragma unroll
        for (int r = 0; r < 19; ++r) { const int t = (first && r < 3) ? t0 : t0 - 3 + r; nx[r] = *(const u32x4*)(X + (size_t)t * 2048 + c0); }
    }
    for (int it = gt; it < total; it += stride) {
        const int t0 = (it >> 8) * 16; const bool first = (t0 & 2047) == 0;
        u32x4 cu[19];
#pragma unroll
        for (int r = 0; r < 19; ++r) cu[r] = nx[r];
        if (it + stride < total) {
            const int t1 = ((it + stride) >> 8) * 16; const bool f1 = (t1 & 2047) == 0;
#pragma unroll
            for (int r = 0; r < 19; ++r) { const int t = (f1 && r < 3) ? t1 : t1 - 3 + r; nx[r] = *(const u32x4*)(X + (size_t)t * 2048 + c0); }
        }
        float p3[8], p2[8], p1[8];
        unpack8(cu[0], p3); unpack8(cu[1], p2); unpack8(cu[2], p1);
        if (first) {
#pragma unroll
            for (int e = 0; e < 8; ++e) { p3[e] = 0.f; p2[e] = 0.f; p1[e] = 0.f; }
        }
#pragma unroll
        for (int r = 0; r < 16; ++r) {
            float cur[8], y[8];
            unpack8(cu[3 + r], cur);
#pragma unroll
            for (int e = 0; e < 8; ++e) { const float v = bb[e] + w0[e] * p3[e] + w1[e] * p2[e] + w2[e] * p1[e] + w3[e] * cur[e]; y[e] = silu_(v); p3[e] = p2[e]; p2[e] = p1[e]; p1[e] = cur[e]; }
            *(u32x4*)(Y + (size_t)(t0 + r) * 2048 + c0) = pack8f(y);
        }
    }
}

DI void gate_scan(const Params& p) {
    const int tid_ = opq(threadIdx.x), lane = tid_ & 63, wid = tid_ >> 6;
    const int bh = blockIdx.x * 8 + wid;
    if (bh >= 128) return;
    const float* LI = (const float*)(p.ws + WS_LI); const float* LF = (const float*)(p.ws + WS_LF);
    float* GP = (float*)(p.ws + WS_GP); float* GQ = (float*)(p.ws + WS_GQ); float* GD = (float*)(p.ws + WS_GD); float* GF = (float*)(p.ws + WS_GF); float* GW = (float*)(p.ws + WS_GW);
    float mcar = 0.f;
    float lfn = LF[(size_t)bh * S_ + lane], lin = LI[(size_t)bh * S_ + lane];
    for (int c = 0; c < 32; ++c) {
        const size_t o = (size_t)bh * S_ + c * 64 + lane;
        const float lf = lfn, li = lin;
        { const size_t on = (c < 31) ? o + 64 : o; lfn = LF[on]; lin = LI[on]; }
        float F = lf;
        F += __int_as_float(__builtin_amdgcn_update_dpp(0, __float_as_int(F), 0x111, 0xf, 0xf, false));
        F += __int_as_float(__builtin_amdgcn_update_dpp(0, __float_as_int(F), 0x112, 0xf, 0xf, false));
        F += __int_as_float(__builtin_amdgcn_update_dpp(0, __float_as_int(F), 0x114, 0xf, 0xf, false));
        F += __int_as_float(__builtin_amdgcn_update_dpp(0, __float_as_int(F), 0x118, 0xf, 0xf, false));
        { const int fi = __float_as_int(F); const float t0 = __int_as_float(__builtin_amdgcn_readlane(fi, 15)), t1 = __int_as_float(__builtin_amdgcn_readlane(fi, 31)), t2 = __int_as_float(__builtin_amdgcn_readlane(fi, 47));
          const int rw = lane >> 4; F += (rw >= 1 ? t0 : 0.f) + (rw >= 2 ? t1 : 0.f) + (rw >= 3 ? t2 : 0.f); }
        const float Qs = li - F;
        float Mx = Qs;
        { const int ninf = __float_as_int(-__builtin_inff());
          Mx = fmaxf(Mx, __int_as_float(__builtin_amdgcn_update_dpp(ninf, __float_as_int(Mx), 0x111, 0xf, 0xf, false)));
          Mx = fmaxf(Mx, __int_as_float(__builtin_amdgcn_update_dpp(ninf, __float_as_int(Mx), 0x112, 0xf, 0xf, false)));
          Mx = fmaxf(Mx, __int_as_float(__builtin_amdgcn_update_dpp(ninf, __float_as_int(Mx), 0x114, 0xf, 0xf, false)));
          Mx = fmaxf(Mx, __int_as_float(__builtin_amdgcn_update_dpp(ninf, __float_as_int(Mx), 0x118, 0xf, 0xf, false)));
          const int mi = __float_as_int(Mx); const float t0 = __int_as_float(__builtin_amdgcn_readlane(mi, 15)), t1 = __int_as_float(__builtin_amdgcn_readlane(mi, 31)), t2 = __int_as_float(__builtin_amdgcn_readlane(mi, 47));
          const int rw = lane >> 4; const float ninff = -__builtin_inff();
          Mx = fmaxf(Mx, fmaxf(fmaxf(rw >= 1 ? t0 : ninff, rw >= 2 ? t1 : ninff), rw >= 3 ? t2 : ninff)); }
        const float a = F + mcar, mt = fmaxf(a, F + Mx);
        const float P = F - mt;
        const float P63 = __int_as_float(__builtin_amdgcn_readlane(__float_as_int(P), 63));
        GP[o] = P; GQ[o] = Qs; GD[o] = __expf(a - mt); GF[o] = __expf(-mt); GW[o] = __expf(P63 + Qs);
        mcar = __int_as_float(__builtin_amdgcn_readlane(__float_as_int(mt), 63));
    }
}

template <int ST> DI bf16x8 pack_step(const f32x16& x) {
    u32x4 r; r[0] = pk2(x[8 * ST], x[8 * ST + 1]); r[1] = pk2(x[8 * ST + 2], x[8 * ST + 3]); r[2] = pk2(x[8 * ST + 4], x[8 * ST + 5]); r[3] = pk2(x[8 * ST + 6], x[8 * ST + 7]);
    return __builtin_bit_cast(bf16x8, r);
}
DI bf16x8 join4(const s16x4& lo, const s16x4& hi) { return __builtin_shufflevector(lo, hi, 0, 1, 2, 3, 4, 5, 6, 7); }
#define MFMA32(a, b, c) __builtin_amdgcn_mfma_f32_32x32x16_bf16((a), (b), (c), 0, 0, 0)
#define TRRD(ptr) __builtin_amdgcn_ds_read_tr16_b64_v4i16((LAS s16x4*)(ptr))

DI void phase_mlstm(const Params& p, unsigned char* shm, const int vb) {
    LAS unsigned char* lds = (LAS unsigned char*)shm;
    constexpr int RS = 528, QI = 0, KI = 64 * RS, VI = KI + 80 * RS, SMI = VI + 64 * RS, SMS = 144;
    constexpr int NS = SMI + 64 * SMS, NACC = NS + 1024, QN = NACC + 1024, RSUM = QN + 256, PC = RSUM + 256, QC = PC + 256, DEC = QC + 256, FLR = DEC + 256, WL = FLR + 256;
    constexpr int PNB = WL + 256;
    static_assert(PNB + 16384 <= LDS_BYTES - 64, "lds");
    const int w = __builtin_amdgcn_readfirstlane(threadIdx.x >> 6);
    const bf16_t* Q = (const bf16_t*)p.out; const bf16_t* Kp = Q + (size_t)T_ * 1024; const bf16_t* V = (const bf16_t*)(p.ws + WS_RC);
    bf16_t* H = (bf16_t*)(p.ws + WS_RA);
    const float* GP = (const float*)(p.ws + WS_GP); const float* GQ = (const float*)(p.ws + WS_GQ); const float* GD = (const float*)(p.ws + WS_GD);
    const float* GF = (const float*)(p.ws + WS_GF); const float* GW = (const float*)(p.ws + WS_GW);
    LAS float* n_s = (LAS float*)(lds + NS); LAS float* nacc = (LAS float*)(lds + NACC); LAS float* qn = (LAS float*)(lds + QN); LAS float* rsum = (LAS float*)(lds + RSUM);
    LAS float* wls = (LAS float*)(lds + WL);
    LAS float* Pc = (LAS float*)(lds + PC); LAS float* Qc = (LAS float*)(lds + QC); LAS float* dec = (LAS float*)(lds + DEC); LAS float* flr = (LAS float*)(lds + FLR);
    for (int unit = vb; unit < 256; unit += gridDim.x) {
        const int bh = (unit & 7) * 16 + (unit >> 4), half = (unit >> 3) & 1, b = bh >> 2, h = bh & 3;
        f32x16 C[8];
        unsigned pf0 = 0u, pf1 = 0u;
#pragma unroll
        for (int i = 0; i < 8; ++i)
#pragma unroll
            for (int e = 0; e < 16; ++e) C[i][e] = 0.f;
        if (threadIdx.x < 256) { n_s[threadIdx.x] = 0.f; nacc[threadIdx.x] = 0.f; }
        { const int tid = threadIdx.x; if (tid < 480) *(LAS u32x4*)(lds + KI + (65 + (tid >> 5)) * RS + 16 * (tid & 31)) = (u32x4){0u, 0u, 0u, 0u}; }
        for (int c = 0; c < 32; ++c) {
            __syncthreads();
            asm volatile("" :: "v"(pf0), "v"(pf1));
            const int t0 = b * S_ + c * 64; const size_t gbase = (size_t)bh * S_ + c * 64;
            {
                const int tid = opq(threadIdx.x), r4 = tid >> 5, cgp = tid & 31;
                if (tid < 64) { Pc[tid] = GP[gbase + tid]; Qc[tid] = GQ[gbase + tid]; dec[tid] = GD[gbase + tid]; flr[tid] = GF[gbase + tid]; wls[tid] = GW[gbase + tid]; rsum[tid] = 0.f; }
                float pn[8];
#pragma unroll
                for (int e = 0; e < 8; ++e) pn[e] = 0.f;
                if (tid < 32) {
                    const f32x4 n0 = *(const LAS f32x4*)(n_s + 8 * cgp), n1 = *(const LAS f32x4*)(n_s + 8 * cgp + 4);
                    u32x4 nb; nb[0] = pk2(n0[0], n0[1]); nb[1] = pk2(n0[2], n0[3]); nb[2] = pk2(n1[0], n1[1]); nb[3] = pk2(n1[2], n1[3]);
                    *(LAS u32x4*)(lds + KI + 64 * RS + 16 * cgp) = nb;
                }
                const bf16_t* qp = Q + (size_t)(t0 + r4) * 1024 + h * 256 + 8 * cgp;
                const bf16_t* kp = Kp + (size_t)(t0 + r4) * 1024 + h * 256 + 8 * cgp;
                const bf16_t* vp = V + (size_t)(t0 + r4) * 2048 + h * 512 + half * 256 + 8 * cgp;
                const int lo_ = r4 * RS + 16 * cgp;
#pragma unroll
                for (int i = 0; i < 4; ++i) {
                    const u32x4 qv = *(const u32x4*)(qp + (size_t)i * 16 * 1024);
                    const u32x4 kv = *(const u32x4*)(kp + (size_t)i * 16 * 1024);
                    const u32x4 vv = *(const u32x4*)(vp + (size_t)i * 16 * 2048);
                    const float wl = GW[gbase + r4 + 16 * i];
                    *(LAS u32x4*)(lds + QI + lo_ + i * 16 * RS) = qv;
                    *(LAS u32x4*)(lds + KI + lo_ + i * 16 * RS) = kv;
                    *(LAS u32x4*)(lds + VI + lo_ + i * 16 * RS) = vv;
                    float f[8];
                    unpack8(kv, f);
#pragma unroll
                    for (int e = 0; e < 8; ++e) pn[e] += wl * f[e];
                }
                *(LAS f32x4*)(lds + PNB + r4 * 1024 + cgp * 32) = (f32x4){pn[0], pn[1], pn[2], pn[3]};
                *(LAS f32x4*)(lds + PNB + r4 * 1024 + cgp * 32 + 16) = (f32x4){pn[4], pn[5], pn[6], pn[7]};
            }
            __syncthreads();
            if (c < 31) {
                const int tid = opq(threadIdx.x), rr = (tid & 255) >> 2, sg = tid & 3;
                const bf16_t* qk = (tid < 256 ? Q : Kp) + (size_t)(t0 + 64 + rr) * 1024 + h * 256 + sg * 64;
                pf0 = *(const unsigned*)qk;
                if (tid < 256) pf1 = *(const unsigned*)(V + (size_t)(t0 + 64 + rr) * 2048 + h * 512 + half * 256 + sg * 64);
            }
            const float d_last = dec[63];
            if (threadIdx.x < 256) { const int tid = threadIdx.x; float a = 0.f;
#pragma unroll
                for (int g = 0; g < 16; ++g) a += *(const LAS float*)(lds + PNB + g * 1024 + tid * 4);
                n_s[tid] = d_last * n_s[tid] + a; }
            {
                const int lane = opq(threadIdx.x) & 63, fr = lane & 15, fq = lane >> 4;
                const int ti = w & 3;
#pragma unroll
                for (int z = 0; z < 2; ++z) {
                    const int si = 2 * (w >> 2) + z;
                    f32x4 a4 = {0.f, 0.f, 0.f, 0.f};
                    if (si <= ti) {
                        const int ka = KI + (16 * si + fr) * RS + 16 * fq, qa = QI + (16 * ti + fr) * RS + 16 * fq;
#pragma unroll
                        for (int kk = 0; kk < 8; ++kk) {
                            const bf16x8 af = *(const LAS bf16x8*)(lds + ka + 64 * kk);
                            const bf16x8 bq = *(const LAS bf16x8*)(lds + qa + 64 * kk);
                            a4 = __builtin_amdgcn_mfma_f32_16x16x32_bf16(af, bq, a4, 0, 0, 0);
                        }
                        const int t = 16 * ti + fr; const float Pt = Pc[t];
                        const f32x4 qs = *(const LAS f32x4*)(Qc + 16 * si + 4 * fq);
                        float rsm = 0.f;
#pragma unroll
                        for (int j = 0; j < 4; ++j) { const int s = 16 * si + 4 * fq + j; const float wg = (s <= t) ? __expf(Pt + qs[j]) : 0.f; a4[j] *= wg; rsm += a4[j]; }
                        rsm += __shfl_xor(rsm, 16); rsm += __shfl_xor(rsm, 32);
                        if (fq == 0) __hip_atomic_fetch_add((float*)(shm + RSUM) + t, rsm, __ATOMIC_RELAXED, __HIP_MEMORY_SCOPE_WORKGROUP);
                    }
                    u32x2 sm; sm[0] = pk2(a4[0], a4[1]); sm[1] = pk2(a4[2], a4[3]);
                    *(LAS u32x2*)(lds + SMI + (16 * ti + fr) * SMS + (16 * si + 4 * fq) * 2) = sm;
                }
                if (w == 4 || w == 5) {
#pragma unroll
                    for (int z = 0; z < 2; ++z) {
                        const int tn = 2 * (w - 4) + z;
                        const int ka = KI + (64 + fr) * RS + 16 * fq, qa = QI + (16 * tn + fr) * RS + 16 * fq;
                        f32x4 a4 = {0.f, 0.f, 0.f, 0.f};
#pragma unroll
                        for (int kk = 0; kk < 8; ++kk) {
                            const bf16x8 af = *(const LAS bf16x8*)(lds + ka + 64 * kk);
                            const bf16x8 bq = *(const LAS bf16x8*)(lds + qa + 64 * kk);
                            a4 = __builtin_amdgcn_mfma_f32_16x16x32_bf16(af, bq, a4, 0, 0, 0);
                        }
                        if (fq == 0) qn[16 * tn + fr] = a4[0];
                    }
                }
            }
            __builtin_amdgcn_sched_barrier(0);
            f32x16 acc2[2];
#pragma unroll
            for (int m = 0; m < 2; ++m)
#pragma unroll
                for (int e = 0; e < 16; ++e) acc2[m][e] = 0.f;
            {
                const int lane = opq(threadIdx.x) & 63, l32 = lane & 31, hh = lane >> 5;
                const int qb = QI + l32 * RS + 8 * hh;
#pragma unroll
                for (int ci = 0; ci < 8; ++ci) {
                    s16x4 lo[2][2], hi[2][2];
#pragma unroll
                    for (int st = 0; st < 2; ++st)
#pragma unroll
                        for (int m2 = 0; m2 < 2; ++m2) { const int off = qb + 32 * m2 * RS + 64 * ci + 32 * st;
                            lo[st][m2] = *(const LAS s16x4*)(lds + off); hi[st][m2] = *(const LAS s16x4*)(lds + off + 16); }
                    const bf16x8 bf0 = pack_step<0>(C[ci]), bf1 = pack_step<1>(C[ci]);
                    __builtin_amdgcn_sched_barrier(0);
#pragma unroll
                    for (int m2 = 0; m2 < 2; ++m2) acc2[m2] = MFMA32(join4(lo[0][m2], hi[0][m2]), bf0, acc2[m2]);
#pragma unroll
                    for (int m2 = 0; m2 < 2; ++m2) acc2[m2] = MFMA32(join4(lo[1][m2], hi[1][m2]), bf1, acc2[m2]);
                    __builtin_amdgcn_sched_barrier(0);
                }
            }
            __syncthreads();
            {
                const int lane = opq(threadIdx.x) & 63, l32 = lane & 31, hh = lane >> 5, q4 = (lane & 15) >> 2, p4 = lane & 3, blk = (lane >> 4) & 1;
#pragma unroll
                for (int m = 0; m < 2; ++m)
#pragma unroll
                    for (int g = 0; g < 4; ++g) { const f32x4 d4 = *(const LAS f32x4*)(dec + 32 * m + 8 * g + 4 * hh);
#pragma unroll
                        for (int e = 0; e < 4; ++e) acc2[m][4 * g + e] *= d4[e]; }
                const int vb = VI + (8 * hh + q4) * RS + (32 * w + 16 * blk) * 2 + 8 * p4, sb = SMI + l32 * SMS + 16 * hh;
#pragma unroll
                for (int kk = 0; kk < 4; ++kk) {
                    const s16x4 lo = TRRD(lds + vb + 16 * kk * RS), hi = TRRD(lds + vb + 16 * kk * RS + 4 * RS);
                    const bf16x8 bf = join4(lo, hi);
#pragma unroll
                    for (int m = 0; m < 2; ++m) { const bf16x8 af = *(const LAS bf16x8*)(lds + sb + 32 * m * SMS + 32 * kk); acc2[m] = MFMA32(af, bf, acc2[m]); }
                }
                const int hb = QI + 4 * hh * RS + (32 * w + l32) * 2;
#pragma unroll
                for (int m = 0; m < 2; ++m)
#pragma unroll
                    for (int g = 0; g < 4; ++g) {
                        const int rb = 32 * m + 8 * g;
                        const f32x4 d4 = *(const LAS f32x4*)(dec + rb + 4 * hh), n4 = *(const LAS f32x4*)(qn + rb + 4 * hh), s4 = *(const LAS f32x4*)(rsum + rb + 4 * hh), f4 = *(const LAS f32x4*)(flr + rb + 4 * hh);
#pragma unroll
                        for (int e = 0; e < 4; ++e) {
                            const float den = d4[e] * n4[e] + s4[e];
                            const float val = acc2[m][4 * g + e] * __builtin_amdgcn_rcpf(fmaxf(fabsf(den), f4[e]));
                            *(LAS bf16_t*)(lds + hb + (rb + e) * RS) = (bf16_t)(pk2(val, 0.f) & 0xffffu);
                        }
                    }
            }
            __builtin_amdgcn_sched_barrier(0);
            {
                const int lane = opq(threadIdx.x) & 63, hh = lane >> 5, q4 = (lane & 15) >> 2, p4 = lane & 3, blk = (lane >> 4) & 1;
                const int tb = (8 * hh + q4) * RS + 32 * blk + 8 * p4;
                bf16x8 bw[4];
#pragma unroll
                for (int kk = 0; kk < 4; ++kk) { const int voff = VI + tb + 64 * w + 16 * kk * RS;
                    const bf16x8 raw = join4(TRRD(lds + voff), TRRD(lds + voff + 4 * RS));
                    const f32x4 w0 = *(const LAS f32x4*)(wls + 16 * kk + 8 * hh), w1 = *(const LAS f32x4*)(wls + 16 * kk + 8 * hh + 4);
                    float f[8]; unpack8(__builtin_bit_cast(u32x4, raw), f);
#pragma unroll
                    for (int e = 0; e < 4; ++e) { f[e] *= w0[e]; f[4 + e] *= w1[e]; }
                    bw[kk] = __builtin_bit_cast(bf16x8, pack8f(f)); }
#pragma unroll
                for (int ci = 0; ci < 8; ++ci) {
                    bf16x8 ka[4];
#pragma unroll
                    for (int kk = 0; kk < 4; ++kk) { const int koff = KI + tb + 64 * ci + 16 * kk * RS; ka[kk] = join4(TRRD(lds + koff), TRRD(lds + koff + 4 * RS)); }
#pragma unroll
                    for (int e = 0; e < 16; ++e) C[ci][e] *= d_last;
                    __builtin_amdgcn_sched_barrier(0);
#pragma unroll
                    for (int kk = 0; kk < 4; ++kk) C[ci] = MFMA32(ka[kk], bw[kk], C[ci]);
                    __builtin_amdgcn_sched_barrier(0);
                }
            }
            __syncthreads();
            {
                const int tid = opq(threadIdx.x), r4 = tid >> 5, cgp = tid & 31;
                bf16_t* hp = H + (size_t)(t0 + r4) * 2048 + h * 512 + half * 256 + 8 * cgp;
#pragma unroll
                for (int i = 0; i < 4; ++i) *(u32x4*)(hp + (size_t)i * 16 * 2048) = *(const LAS u32x4*)(lds + QI + (r4 + 16 * i) * RS + 16 * cgp);
            }
        }
        __syncthreads();
    }
}


DI void phase_post(const Params& p) {
    const int tid_ = opq(threadIdx.x), lane = tid_ & 63, wid = tid_ >> 6;
    const int gw = blockIdx.x * 8 + wid, nw = gridDim.x * 8;
    bf16_t* H = (bf16_t*)(p.ws + WS_RA); const bf16_t* O = (const bf16_t*)p.out; const bf16_t* XC = (const bf16_t*)(p.ws + WS_RB); const bf16_t* Z = (const bf16_t*)(p.ws + WS_RC);
    const float* nwp = p.in[11]; const float* skp = p.in[12];
    u32x4 nh, no, nx, nz;
    { const size_t b0 = (size_t)(gw >> 2) * 2048 + (gw & 3) * 512 + lane * 8; nh = *(const u32x4*)(H + b0); no = *(const u32x4*)(O + b0); nx = *(const u32x4*)(XC + b0); nz = *(const u32x4*)(Z + b0); }
    for (int u = gw; u < T_ * 4; u += nw) {
        const int hd = u & 3; const size_t base = (size_t)(u >> 2) * 2048 + hd * 512 + lane * 8;
        float hv[8], ov[8], xv[8], zv[8];
        unpack8(nh, hv); unpack8(no, ov); unpack8(nx, xv); unpack8(nz, zv);
        { const int un = (u + nw < T_ * 4) ? u + nw : u; const size_t bn = (size_t)(un >> 2) * 2048 + (un & 3) * 512 + lane * 8;
          nh = *(const u32x4*)(H + bn); no = *(const u32x4*)(O + bn); nx = *(const u32x4*)(XC + bn); nz = *(const u32x4*)(Z + bn); }
        float s = 0.f;
#pragma unroll
        for (int e = 0; e < 8; ++e) { hv[e] *= sigm(ov[e]); s += hv[e]; }
        const float mu = wave_sum(s) * (1.f / 512.f);
        float s2 = 0.f;
#pragma unroll
        for (int e = 0; e < 8; ++e) { hv[e] -= mu; s2 += hv[e] * hv[e]; }
        const float r = __builtin_amdgcn_rsqf(wave_sum(s2) * (1.f / 512.f) + EPS_);
        const f32x4 nw0 = *(const f32x4*)(nwp + hd * 512 + lane * 8), nw1 = *(const f32x4*)(nwp + hd * 512 + lane * 8 + 4);
        const f32x4 sk0 = *(const f32x4*)(skp + hd * 512 + lane * 8), sk1 = *(const f32x4*)(skp + hd * 512 + lane * 8 + 4);
        float y[8];
#pragma unroll
        for (int e = 0; e < 4; ++e) { y[e] = (hv[e] * r * nw0[e] + sk0[e] * xv[e]) * silu_(zv[e]); y[4 + e] = (hv[4 + e] * r * nw1[e] + sk1[e] * xv[4 + e]) * silu_(zv[4 + e]); }
        *(u32x4*)(H + base) = pack8f(y);
    }
}

DI void phase_scan(const Params& p, unsigned char* shm) {
    LAS unsigned char* lds = (LAS unsigned char*)shm;
    constexpr int TR = 400, TSZ = 64 * TR;
    const bf16_t* LA = (const bf16_t*)(p.ws + WS_LA); const bf16_t* BT = (const bf16_t*)(p.ws + WS_BT); const bf16_t* G = (const bf16_t*)(p.ws + WS_RC);
    bf16_t* Y = (bf16_t*)(p.ws + WS_RB);
    const int tid = opq(threadIdx.x);
    for (int unit = blockIdx.x; unit < 256; unit += gridDim.x) {
        const int b = unit >> 3, cg0 = (unit & 7) * 192;
        int goff[3], loff[3];
#pragma unroll
        for (int j = 0; j < 3; ++j) { const int q = tid + 512 * j, row = q / 24, cc = q % 24; goff[j] = row * 1536 + cc * 8; loff[j] = row * TR + cc * 16; }
        const size_t base = (size_t)b * S_ * 1536 + cg0;
        u32x4 ra[3], rb[3], rg[3];
#pragma unroll
        for (int j = 0; j < 3; ++j) { ra[j] = *(const u32x4*)(LA + base + goff[j]); rb[j] = *(const u32x4*)(BT + base + goff[j]); rg[j] = *(const u32x4*)(G + base + goff[j]); }
        float hst = 0.f;
        for (int tile = 0; tile < 32; ++tile) {
            __syncthreads();
#pragma unroll
            for (int j = 0; j < 3; ++j) { *(LAS u32x4*)(lds + loff[j]) = ra[j]; *(LAS u32x4*)(lds + TSZ + loff[j]) = rb[j]; *(LAS u32x4*)(lds + 2 * TSZ + loff[j]) = rg[j]; }
            if (tile < 31) {
                const size_t nb = base + (size_t)(tile + 1) * 64 * 1536;
#pragma unroll
                for (int j = 0; j < 3; ++j) { ra[j] = *(const u32x4*)(LA + nb + goff[j]); rb[j] = *(const u32x4*)(BT + nb + goff[j]); rg[j] = *(const u32x4*)(G + nb + goff[j]); }
            }
            __syncthreads();
            if (tid < 192) {
#pragma unroll 8
                for (int r = 0; r < 64; ++r) {
                    const float la = __uint_as_float((unsigned)*(const LAS bf16_t*)(lds + r * TR + tid * 2) << 16);
                    const float bt = __uint_as_float((unsigned)*(const LAS bf16_t*)(lds + TSZ + r * TR + tid * 2) << 16);
                    const float g = __uint_as_float((unsigned)*(const LAS bf16_t*)(lds + 2 * TSZ + r * TR + tid * 2) << 16);
                    hst = __expf(la) * hst + bt;
                    *(LAS bf16_t*)(lds + 2 * TSZ + r * TR + tid * 2) = (bf16_t)(pk2(hst * g, 0.f) & 0xffffu);
                }
            }
            __syncthreads();
            const size_t ob = base + (size_t)tile * 64 * 1536;
#pragma unroll
            for (int j = 0; j < 3; ++j) *(u32x4*)(Y + ob + goff[j]) = *(const LAS u32x4*)(lds + 2 * TSZ + loff[j]);
        }
        __syncthreads();
    }
}

DI void phase_rglru(const Params& p, unsigned char* shm) {
    LAS unsigned char* lds = (LAS unsigned char*)shm;
    constexpr int TR = 400, XR = 0, XC = 26880, GT = XC + 25600, LAo = GT + 25600, BTo = LAo + 25600, CW = BTo + 25600, GB = CW + 3840;
    static_assert(GB + 2304 <= LDS_BYTES, "lds");
    const int tid = opq(threadIdx.x), lane = tid & 63, w = __builtin_amdgcn_readfirstlane(tid >> 6), fr = lane & 15, fq = lane >> 4;
    const bf16_t* XRg = (const bf16_t*)(p.ws + WS_RA); const bf16_t* Gg = (const bf16_t*)(p.ws + WS_RC); bf16_t* Y = (bf16_t*)(p.ws + WS_RB);
    const bf16_t* WG2 = (const bf16_t*)(p.ws + WS_WT_G); const float* SPp = (const float*)(p.ws + WS_SP);
    LAS float* cw = (LAS float*)(lds + CW); LAS float* gb = (LAS float*)(lds + GB);
    for (int unit = blockIdx.x; unit < 256; unit += gridDim.x) {
        const int b = unit >> 3, blk = unit & 7, cg0 = blk * 192;
        __syncthreads();
        for (int i = tid; i < 960; i += 512) { const int j = i / 192, c = i % 192; cw[i] = j < 4 ? p.in[15][j * 1536 + cg0 + c] : p.in[16][cg0 + c]; }
        for (int i = tid; i < 576; i += 512) { const int k = i / 192, c = i % 192; gb[i] = (k == 0 ? p.in[18] : (k == 1 ? p.in[20] : SPp))[cg0 + c]; }
        if (tid < 72) *(LAS u32x4*)(lds + XR + (tid / 24) * TR + (tid % 24) * 16) = (u32x4){0u, 0u, 0u, 0u};
        bf16x8 Bf[4][6];
        const int chb = w < 4 ? 32 * w : 128 + 16 * (w - 4);
        {
#pragma unroll
          for (int nt = 0; nt < 4; ++nt)
#pragma unroll
              for (int kk = 0; kk < 6; ++kk) {
                  const int chn = chb + ((w < 4) ? 16 * (nt & 1) : 0) + fr;
                  Bf[nt][kk] = *(const bf16x8*)(WG2 + ((size_t)((blk * 2 + (nt >> 1)) * 192 + chn) * 192 + 32 * kk + 8 * fq)); } }
        int goff[3], loff[3];
#pragma unroll
        for (int j = 0; j < 3; ++j) { const int q = tid + 512 * j, row = q / 24, cc = q % 24; goff[j] = row * 1536 + cc * 8; loff[j] = row * TR + cc * 16; }
        const size_t base = (size_t)b * S_ * 1536 + cg0;
        u32x4 rx[3], rg[3];
#pragma unroll
        for (int j = 0; j < 3; ++j) { rx[j] = *(const u32x4*)(XRg + base + goff[j]); rg[j] = *(const u32x4*)(Gg + base + goff[j]); }
        float hst = 0.f;
        for (int tile = 0; tile < 32; ++tile) {
            __syncthreads();
#pragma unroll
            for (int j = 0; j < 3; ++j) { *(LAS u32x4*)(lds + XR + 3 * TR + loff[j]) = rx[j]; *(LAS u32x4*)(lds + GT + loff[j]) = rg[j]; }
            if (tile < 31) {
                const size_t nb = base + (size_t)(tile + 1) * 64 * 1536;
#pragma unroll
                for (int j = 0; j < 3; ++j) { rx[j] = *(const u32x4*)(XRg + nb + goff[j]); rg[j] = *(const u32x4*)(Gg + nb + goff[j]); }
            }
            __syncthreads();
#pragma unroll
            for (int j = 0; j < 3; ++j) {
                const int q = tid + 512 * j, cc = q % 24;
                float a8[8];
                { const f32x4 b0 = *(const LAS f32x4*)(cw + 768 + 8 * cc), b1 = *(const LAS f32x4*)(cw + 768 + 8 * cc + 4);
#pragma unroll
                  for (int e = 0; e < 4; ++e) { a8[e] = b0[e]; a8[4 + e] = b1[e]; } }
#pragma unroll
                for (int jj = 0; jj < 4; ++jj) {
                    float xin[8]; { const u32x4 xraw = *(const LAS u32x4*)(lds + XR + jj * TR + loff[j]); unpack8(xraw, xin); }
                    const f32x4 w0 = *(const LAS f32x4*)(cw + jj * 192 + 8 * cc), w1 = *(const LAS f32x4*)(cw + jj * 192 + 8 * cc + 4);
#pragma unroll
                    for (int e = 0; e < 4; ++e) { a8[e] += w0[e] * xin[e]; a8[4 + e] += w1[e] * xin[4 + e]; }
                }
                *(LAS u32x4*)(lds + XC + loff[j]) = pack8f(a8);
            }
            __syncthreads();
            {
#pragma unroll
                for (int u = 0; u < 2; ++u) {
                    if (u == 1 && w >= 4) break;
                    f32x4 acc[4][2];
#pragma unroll
                    for (int mt = 0; mt < 4; ++mt) { acc[mt][0] = (f32x4){0.f, 0.f, 0.f, 0.f}; acc[mt][1] = (f32x4){0.f, 0.f, 0.f, 0.f}; }
#pragma unroll
                    for (int kk = 0; kk < 6; ++kk)
#pragma unroll
                        for (int mt = 0; mt < 4; ++mt) {
                            const bf16x8 af = *(const LAS bf16x8*)(lds + XC + (16 * mt + fr) * TR + (32 * kk + 8 * fq) * 2);
                            acc[mt][0] = __builtin_amdgcn_mfma_f32_16x16x32_bf16(af, Bf[u][kk], acc[mt][0], 0, 0, 0);
                            acc[mt][1] = __builtin_amdgcn_mfma_f32_16x16x32_bf16(af, Bf[2 + u][kk], acc[mt][1], 0, 0, 0);
                        }
                    const int ch = chb + 16 * u + fr;
                    const float ba = gb[ch], bx = gb[192 + ch], sp = gb[384 + ch];
#pragma unroll
                    for (int mt = 0; mt < 4; ++mt)
#pragma unroll
                        for (int j = 0; j < 4; ++j) {
                            const int t = 16 * mt + 4 * fq + j;
                            const float ea = 1.f + __expf(fminf(-(acc[mt][0][j] + ba), 40.f)), ex = 1.f + __expf(fminf(-(acc[mt][1][j] + bx), 40.f));
                            const float inv = __builtin_amdgcn_rcpf(ea * ex);
                            const float r = inv * ex, ig = inv * ea;
                            const float av = __expf(r * sp), om = 1.f - av;
                            const float xcv = __uint_as_float((unsigned)*(const LAS bf16_t*)(lds + XC + t * TR + ch * 2) << 16);
                            const float bt = __builtin_amdgcn_sqrtf(fmaxf(om * (1.f + av), 0.f)) * (ig * xcv);
                            *(LAS bf16_t*)(lds + LAo + t * TR + ch * 2) = (bf16_t)(pk2(om, 0.f) & 0xffffu);
                            *(LAS bf16_t*)(lds + BTo + t * TR + ch * 2) = (bf16_t)(pk2(bt, 0.f) & 0xffffu);
                        }
                    __builtin_amdgcn_sched_barrier(0);
                }
            }
            __syncthreads();
            if (tid < 192) {
#pragma unroll 8
                for (int r = 0; r < 64; ++r) {
                    const float om = __uint_as_float((unsigned)*(const LAS bf16_t*)(lds + LAo + r * TR + tid * 2) << 16);
                    const float bt = __uint_as_float((unsigned)*(const LAS bf16_t*)(lds + BTo + r * TR + tid * 2) << 16);
                    const float g = __uint_as_float((unsigned)*(const LAS bf16_t*)(lds + GT + r * TR + tid * 2) << 16);
                    hst = (hst - om * hst) + bt;
                    *(LAS bf16_t*)(lds + GT + r * TR + tid * 2) = (bf16_t)(pk2(hst * g, 0.f) & 0xffffu);
                }
            } else if (tid >= 256 && tid < 328) {
                const int i = tid - 256, r = i / 24, cc = i % 24;
                const u32x4 v = *(const LAS u32x4*)(lds + XR + (64 + r) * TR + cc * 16);
                *(LAS u32x4*)(lds + XR + r * TR + cc * 16) = v;
            }
            __syncthreads();
            const size_t ob = base + (size_t)tile * 64 * 1536;
#pragma unroll
            for (int j = 0; j < 3; ++j) *(u32x4*)(Y + ob + goff[j]) = *(const LAS u32x4*)(lds + GT + loff[j]);
        }
        __syncthreads();
    }
}


#define XB_TMO      128
#define XB_XCNT(j)  (256  + 64 * (j))
#define XB_XSUB(j)  (1280 + 64 * (j))
#define XB_XGEN(j)  (2304 + 64 * (j))
#define XB_TOP      3328
#define XB_TOPGEN   3392
#define XCD_BAR_WORDS 3456
#define XB_SPIN_CAP (1u << 18)
DI unsigned xb_ld(unsigned* p)              { return __hip_atomic_load(p, __ATOMIC_RELAXED, __HIP_MEMORY_SCOPE_AGENT); }
DI unsigned xb_add(unsigned* p, unsigned v) { return __hip_atomic_fetch_add(p, v, __ATOMIC_RELAXED, __HIP_MEMORY_SCOPE_AGENT); }
DI unsigned xb_xcc_id() { return (unsigned)__builtin_amdgcn_s_getreg((3 << 11) | 20) & 0xFu; }
#define XB_SPIN(cond, bar) do { unsigned _sp = 0; while (cond) { __builtin_amdgcn_s_sleep(1); \
    if ((++_sp & 255u) == 0u) { if (xb_ld(&(bar)[XB_TMO])) break; if (_sp > XB_SPIN_CAP) { atomicAdd(&(bar)[XB_TMO], 1u); break; } } } } while (0)
struct XcdBarrier { unsigned* bar; unsigned x; volatile LAS unsigned* st; };
DI XcdBarrier xcd_barrier_post(unsigned* bar, volatile LAS unsigned* st) {
    XcdBarrier b; b.bar = bar; b.x = xb_xcc_id(); b.st = st;
    if (threadIdx.x == 0) st[2] = xb_add(&bar[XB_XCNT(b.x)], 1u);
    return b;
}
DI void xcd_barrier_complete(unsigned* bar, unsigned x, unsigned& nloc, unsigned& nx) {
    const unsigned G = gridDim.x * gridDim.y * gridDim.z;
    unsigned sum, cnt, mine, sp = 0u;
    for (;;) {
        sum = 0u; cnt = 0u; mine = 0u;
#pragma unroll
        for (unsigned j = 0; j < 16; ++j) { const unsigned c = xb_ld(&bar[XB_XCNT(j)]); sum += c; cnt += (c > 0u) ? 1u : 0u; mine = (j == x) ? c : mine; }
        if (sum == G) break;
        __builtin_amdgcn_s_sleep(1);
        if ((++sp & 255u) == 0u) { if (xb_ld(&bar[XB_TMO])) break; if (sp > XB_SPIN_CAP) { atomicAdd(&bar[XB_TMO], 1u); break; } }
    }
    nloc = mine > 0u ? mine : 1u; nx = cnt > 0u ? cnt : 1u;
}
DI void xcd_barrier(const XcdBarrier& b) {
    asm volatile("s_waitcnt vmcnt(0)" ::: "memory");
    __syncthreads();
    if (threadIdx.x == 0) {
        unsigned* bar = b.bar;
        __builtin_amdgcn_s_waitcnt(0);
        unsigned nloc = b.st[0], nx = b.st[1];
        if (nloc == 0u) { xcd_barrier_complete(bar, b.x, nloc, nx); b.st[0] = nloc; b.st[1] = nx; }
        const unsigned old = xb_add(&bar[XB_XSUB(b.x)], 1u);
        const unsigned gen = old / nloc;
        if (old + 1u == (gen + 1u) * nloc) {
            __builtin_amdgcn_fence(__ATOMIC_RELEASE, "agent");
            asm volatile("s_waitcnt vmcnt(0)" ::: "memory");
            const unsigned og = xb_add(&bar[XB_TOP], 1u);
            const unsigned tg = og / nx;
            if (og + 1u == (tg + 1u) * nx) xb_add(&bar[XB_TOPGEN], 1u);
            else XB_SPIN(xb_ld(&bar[XB_TOPGEN]) == tg, bar);
            __builtin_amdgcn_fence(__ATOMIC_ACQUIRE, "agent");
            xb_add(&bar[XB_XGEN(b.x)], 1u);
            asm volatile("s_waitcnt vmcnt(0)" ::: "memory");
        } else {
            XB_SPIN(xb_ld(&bar[XB_XGEN(b.x)]) == gen, bar);
            __builtin_amdgcn_fence(__ATOMIC_ACQUIRE, "agent");
            asm volatile("s_waitcnt vmcnt(0)" ::: "memory");
        }
    }
    __syncthreads();
}

__global__ void __launch_bounds__(512) hybrid_fwd(Params p) {
    extern __shared__ __attribute__((aligned(16))) unsigned char shm[];
    LAS unsigned char* lds = (LAS unsigned char*)shm;
    cg::grid_group grid = cg::this_grid();
    volatile LAS unsigned* xst = (volatile LAS unsigned*)(lds + 140272);
    if (threadIdx.x == 0) { xst[0] = 0u; xst[1] = 0u; }
    __syncthreads();
    if (blockIdx.x == 0) { unsigned* bw = (unsigned*)(p.ws + WS_BAR); for (int i = threadIdx.x; i < XCD_BAR_WORDS; i += 512) bw[i] = 0u; }
    grid.sync();
    XcdBarrier xb = xcd_barrier_post((unsigned*)(p.ws + WS_BAR), xst);
    unsigned char* ws = p.ws;
    bf16_t* U = (bf16_t*)(ws + WS_U); bf16_t* RA = (bf16_t*)(ws + WS_RA); bf16_t* RB = (bf16_t*)(ws + WS_RB); bf16_t* RC = (bf16_t*)(ws + WS_RC);
    bf16_t* OUTB = (bf16_t*)p.out;

    PH_BEGIN(0)
    phase_prep(p, shm);
    PH_END
    int vb;
    { if (threadIdx.x == 0) {
          unsigned* bw = (unsigned*)(p.ws + WS_BAR); bool ok = (gridDim.x % 8u) == 0u && xb.x < 8u;
          for (unsigned j = 0; j < 8; ++j) ok = ok && (xb_ld(&bw[XB_XCNT(j)]) == gridDim.x / 8u);
          xst[3] = ok ? (xst[2] * 8u + xb.x) : blockIdx.x; }
      __syncthreads();
      vb = __builtin_amdgcn_readfirstlane((int)xst[3]); }
    PH_BEGIN(1)
    { const char* A = (const char*)U; const char* B = (const char*)(ws + WS_WT_XM);
      gemm_phase<true>(lds, 256, 8, 1024, 1024, 1024,
          [=](int pm, int pn, const char*& a, const char*& b) { a = A + (size_t)pm * 256 * 1024 * 2; b = B + (size_t)pn * 256 * 1024 * 2; },
          [=](const f32x4 (&acc)[2][2][4][2], int pm, int pn, int wr, int wc, int fr, int fq) { epi_bf16<0>(acc, RA + (size_t)pm * 256 * 2048 + pn * 256, 2048, wr, wc, fr, fq); }, vb); }
    PH_END
    PH_BEGIN(2)
    if (blockIdx.x < 16) gate_scan(p);
    conv0_phase(RA, p.in[4], p.in[5], RB);
    PH_END
    PH_BEGIN(3)
    { const char* XC = (const char*)RB; const char* XM = (const char*)RA; const char* WQK = (const char*)(ws + WS_WT_QK); const char* WV = (const char*)(ws + WS_WT_V);
      gemm_phase<true>(lds, 256, 16, 512, 2048, 512,
          [=](int pm, int pn, const char*& a, const char*& b) {
              if (pn < 8) { a = XC + ((size_t)pm * 256 * 2048 + (pn >> 1) * 512) * 2; b = WQK + (size_t)pn * 256 * 512 * 2; }
              else { a = XM + ((size_t)pm * 256 * 2048 + ((pn - 8) >> 1) * 512) * 2; b = WV + (size_t)(pn - 8) * 256 * 512 * 2; } },
          [=](const f32x4 (&acc)[2][2][4][2], int pm, int pn, int wr, int wc, int fr, int fq) {
              if (pn < 8) epi_bf16<0>(acc, OUTB + (size_t)(pn & 1) * T_ * 1024 + (size_t)pm * 256 * 1024 + (pn >> 1) * 256, 1024, wr, wc, fr, fq);
              else epi_bf16<0>(acc, RC + (size_t)pm * 256 * 2048 + (pn - 8) * 256, 2048, wr, wc, fr, fq); }, vb); }
    PH_END
    PH_BEGIN(4)
    phase_mlstm(p, shm, vb);
    PH_END
    PH_BEGIN(5)
    { const char* A = (const char*)U; const char* B = (const char*)(ws + WS_WT_ZO);
      gemm_phase<true>(lds, 256, 16, 1024, 1024, 1024,
          [=](int pm, int pn, const char*& a, const char*& b) { a = A + (size_t)pm * 256 * 1024 * 2; b = B + (size_t)pn * 256 * 1024 * 2; },
          [=](const f32x4 (&acc)[2][2][4][2], int pm, int pn, int wr, int wc, int fr, int fq) {
              if (pn < 8) epi_bf16<0>(acc, RC + (size_t)pm * 256 * 2048 + pn * 256, 2048, wr, wc, fr, fq);
              else epi_bf16<0>(acc, OUTB + (size_t)pm * 256 * 2048 + (pn - 8) * 256, 2048, wr, wc, fr, fq); }, vb); }
    PH_END
    PH_BEGIN(6)
    phase_post(p);
    PH_END
    PH_BEGIN(7)
    { const char* A = (const char*)RA; const char* B = (const char*)(ws + WS_WT_OUT0); const float* X = p.in[0]; float* X1 = p.out; float* SS1 = (float*)(ws + WS_SS1);
      gemm_phase<false>(lds, 256, 4, 2048, 2048, 2048,
          [=](int pm, int pn, const char*& a, const char*& b) { a = A + (size_t)pm * 256 * 2048 * 2; b = B + (size_t)pn * 256 * 2048 * 2; },
          [=](const f32x4 (&acc)[2][2][4][2], int pm, int pn, int wr, int wc, int fr, int fq) {
#pragma unroll
              for (int ai = 0; ai < 2; ++ai)
#pragma unroll
                  for (int m = 0; m < 4; ++m) { const int row = pm * 256 + ai * 128 + wr * 64 + m * 16 + fr; const size_t ro = (size_t)row * 1024 + pn * 256 + wc * 32 + 4 * fq;
                      float ssq = 0.f;
#pragma unroll
                      for (int bj = 0; bj < 2; ++bj)
#pragma unroll
                          for (int n = 0; n < 2; ++n) { const size_t o = ro + bj * 128 + n * 16; const f32x4 v = *(const f32x4*)(X + o) + acc[ai][bj][m][n];
                              u32x2 wv; wv[0] = pk2(v[0], v[1]); wv[1] = pk2(v[2], v[3]); *(u32x2*)(U + o) = wv;
                              ssq += v[0] * v[0] + v[1] * v[1] + v[2] * v[2] + v[3] * v[3]; }
                      ssq += __shfl_xor(ssq, 16); ssq += __shfl_xor(ssq, 32);
                      if (fq == 0) unsafeAtomicAdd(SS1 + row, ssq); } }, vb); }
    PH_END
    PH_BEGIN(9)
    { const char* A = (const char*)U; const char* B = (const char*)(ws + WS_WT_IN1);
      gemm_phase<true>(lds, 256, 12, 1024, 1024, 1024,
          [=](int pm, int pn, const char*& a, const char*& b) { a = A + (size_t)pm * 256 * 1024 * 2; b = B + (size_t)pn * 256 * 1024 * 2; },
          [=](const f32x4 (&acc)[2][2][4][2], int pm, int pn, int wr, int wc, int fr, int fq) {
              const float* ssr = (const float*)(ws + WS_SS1) + pm * 256;
              if (pn < 6) epi_bf16<0>(acc, RA + (size_t)pm * 256 * 1536 + pn * 256, 1536, wr, wc, fr, fq, ssr);
              else epi_bf16<1>(acc, RC + (size_t)pm * 256 * 1536 + (pn - 6) * 256, 1536, wr, wc, fr, fq, ssr); }, vb); }
    PH_END
    PH_BEGIN(10)
    phase_rglru(p, shm);
    PH_END
    { const char* A = (const char*)RB; const char* B = (const char*)(ws + WS_WT_OUT1); bf16_t* X2B = RA; const f32x4* fg = (const f32x4*)p.in[2]; f32x4* O4 = (f32x4*)p.out;
      LAS float* rowss = (LAS float*)(lds + 131072);
      for (int panel = vb; panel < 256; panel += gridDim.x) {
          { const int tid = opq(threadIdx.x); if (tid < 256) rowss[tid] = 0.f; }
          __syncthreads();
          gemm_phase<false>(lds, 256, 4, 1536, 1536, 1536,
              [=](int pm, int pn, const char*& a, const char*& b) { a = A + (size_t)pm * 256 * 1536 * 2; b = B + (size_t)pn * 256 * 1536 * 2; },
              [=](const f32x4 (&acc)[2][2][4][2], int pm, int pn, int wr, int wc, int fr, int fq) {
#pragma unroll
                  for (int ai = 0; ai < 2; ++ai)
#pragma unroll
                      for (int m = 0; m < 4; ++m) { const int rl = ai * 128 + wr * 64 + m * 16 + fr; const size_t ro = (size_t)(pm * 256 + rl) * 1024 + pn * 256 + wc * 32 + 4 * fq;
                          float ssq = 0.f;
#pragma unroll
                          for (int bj = 0; bj < 2; ++bj)
#pragma unroll
                              for (int n = 0; n < 2; ++n) { const size_t o = ro + bj * 128 + n * 16; const u32x2 xb = *(const u32x2*)(U + o);
                                  const f32x4 v = (f32x4){bflo(xb[0]), bfhi(xb[0]), bflo(xb[1]), bfhi(xb[1])} + acc[ai][bj][m][n];
                                  u32x2 wv; wv[0] = pk2(v[0], v[1]); wv[1] = pk2(v[2], v[3]); *(u32x2*)(X2B + o) = wv;
                                  ssq += v[0] * v[0] + v[1] * v[1] + v[2] * v[2] + v[3] * v[3]; }
                          ssq += __shfl_xor(ssq, 16); ssq += __shfl_xor(ssq, 32);
                          if (fq == 0) __hip_atomic_fetch_add((float*)(shm + 131072) + rl, ssq, __ATOMIC_RELAXED, __HIP_MEMORY_SCOPE_WORKGROUP); } }, vb, panel);
          asm volatile("s_waitcnt vmcnt(0)" ::: "memory");
          __syncthreads();
          { const int tid = opq(threadIdx.x);
            for (int idx = tid; idx < 256 * 128; idx += 512) {
                const int row = idx >> 7, c = idx & 127; const size_t go = (size_t)(panel * 256 + row);
                const u32x4 xb = *(const u32x4*)(X2B + go * 1024 + c * 8);
                const float r = __builtin_amdgcn_rsqf(rowss[row] * (1.f / 1024.f) + EPS_);
                float f[8]; unpack8(xb, f);
                const f32x4 g0 = fg[2 * c], g1 = fg[2 * c + 1];
                O4[go * 256 + 2 * c] = (f32x4){f[0], f[1], f[2], f[3]} * r * g0;
                O4[go * 256 + 2 * c + 1] = (f32x4){f[4], f[5], f[6], f[7]} * r * g1; } }
          __syncthreads();
      } }
}

extern "C" void kernel_launch(void* const* d_in, const int* in_sizes, int n_in, void* d_out, int out_size, void* d_ws, size_t ws_size, hipStream_t stream) {
    static int grid_blocks = 0;
    if (!grid_blocks) {
        int dev = 0, cus = 0, per_cu = 0;
        hipGetDevice(&dev);
        hipDeviceGetAttribute(&cus, hipDeviceAttributeMultiprocessorCount, dev);
        hipFuncSetAttribute((const void*)hybrid_fwd, hipFuncAttributeMaxDynamicSharedMemorySize, LDS_BYTES);
        hipOccupancyMaxActiveBlocksPerMultiprocessor(&per_cu, (const void*)hybrid_fwd, 512, LDS_BYTES);
        if (per_cu < 1) { fprintf(stderr, "occupancy query returned %d\n", per_cu); per_cu = 1; }
        grid_blocks = cus * per_cu;
        if (grid_blocks > 256) grid_blocks = 256;
    }
    Params p{};
    for (int i = 0; i < 23; ++i) p.in[i] = (const float*)d_in[i];
    p.out = (float*)d_out; p.ws = (unsigned char*)d_ws; p.rep_mask = REP_MASK;
    void* args[] = {&p};
    hipError_t e = hipLaunchCooperativeKernel((const void*)hybrid_fwd, dim3(grid_blocks), dim3(512), args, LDS_BYTES, stream);
    if (e != hipSuccess) fprintf(stderr, "cooperative launch failed: %s (grid %d)\n", hipGetErrorString(e), grid_blocks);
}
```

```cpp
#include <hip/hip_runtime.h>
#include <hip/hip_cooperative_groups.h>
#include <cstdio>
namespace cg = cooperative_groups;

#define DI __device__ __forceinline__
#define LAS __attribute__((address_space(3)))
typedef unsigned short bf16_t;
typedef short bf16x8 __attribute__((ext_vector_type(8)));
typedef short s16x4 __attribute__((ext_vector_type(4)));
typedef float f32x2 __attribute__((ext_vector_type(2)));
typedef float f32x4 __attribute__((ext_vector_type(4)));
typedef float f32x16 __attribute__((ext_vector_type(16)));
typedef unsigned u32x2 __attribute__((ext_vector_type(2)));
typedef unsigned u32x4 __attribute__((ext_vector_type(4)));
typedef __bf16 bf2_t __attribute__((ext_vector_type(2)));

constexpr int T_ = 65536, S_ = 2048;
constexpr float EPS_ = 1e-6f;
constexpr size_t MB_ = 1u << 20;
constexpr size_t WS_WT_XM = 0, WS_WT_ZO = 4 * MB_, WS_WT_QK = 12 * MB_, WS_WT_V = 14 * MB_, WS_WT_OUT0 = 16 * MB_, WS_WT_IN1 = 20 * MB_,
                 WS_WT_G = 26 * MB_, WS_WT_OUT1 = 28 * MB_, WS_LI = 31 * MB_, WS_LF = 32 * MB_, WS_GP = 33 * MB_, WS_GQ = 34 * MB_, WS_GD = 35 * MB_,
                 WS_GF = 36 * MB_, WS_GW = 37 * MB_, WS_SS = 38 * MB_, WS_U = 40 * MB_, WS_RA = 168 * MB_, WS_RB = 424 * MB_, WS_RC = 680 * MB_,
                 WS_LA = 40 * MB_, WS_BT = 232 * MB_, WS_SP = 39 * MB_, WS_SS1 = 38 * MB_ + 512 * 1024, WS_BAR = 39 * MB_ + 65536;
constexpr int LDS_BYTES = 140288;

struct Params { const float* in[23]; float* out; unsigned char* ws; unsigned rep_mask; unsigned pad; };
#ifndef REP_MASK
#define REP_MASK 0u
#endif
#ifndef PH_MASK
#define PH_MASK 0xffffu
#endif
#define PH_BEGIN(k) for (int r_ = 0, n_ = ((PH_MASK >> (k)) & 1u) ? 1 + (int)((p.rep_mask >> (k)) & 1u) : 0; r_ < n_; ++r_) {
#define PH_END xcd_barrier(xb); }
#define PH_END_CG grid.sync(); }

DI unsigned pk2(float a, float b) { f32x2 v = {a, b}; bf2_t r = __builtin_convertvector(v, bf2_t); return __builtin_bit_cast(unsigned, r); }
DI int opq(int x) { asm volatile("" : "+v"(x)); return x; }
DI float bflo(unsigned u) { return __uint_as_float(u << 16); }
DI float bfhi(unsigned u) { return __uint_as_float(u & 0xffff0000u); }
DI float sigm(float x) { return __builtin_amdgcn_rcpf(1.f + __expf(-x)); }
DI float silu_(float x) { return x * __builtin_amdgcn_rcpf(1.f + __expf(-x)); }
DI float wave_sum(float v) {
    v += __int_as_float(__builtin_amdgcn_update_dpp(0, __float_as_int(v), 0xB1, 0xf, 0xf, true));
    v += __int_as_float(__builtin_amdgcn_update_dpp(0, __float_as_int(v), 0x4E, 0xf, 0xf, true));
    v += __int_as_float(__builtin_amdgcn_update_dpp(0, __float_as_int(v), 0x141, 0xf, 0xf, true));
    v += __int_as_float(__builtin_amdgcn_update_dpp(0, __float_as_int(v), 0x140, 0xf, 0xf, true));
    const int vi = __float_as_int(v);
    return (__int_as_float(__builtin_amdgcn_readlane(vi, 0)) + __int_as_float(__builtin_amdgcn_readlane(vi, 16))) +
           (__int_as_float(__builtin_amdgcn_readlane(vi, 32)) + __int_as_float(__builtin_amdgcn_readlane(vi, 48)));
}
DI void unpack8(const u32x4& u, float (&f)[8]) {
#pragma unroll
    for (int i = 0; i < 4; ++i) { f[2 * i] = bflo(u[i]); f[2 * i + 1] = bfhi(u[i]); }
}
DI u32x4 pack8f(const float (&f)[8]) { u32x4 r; r[0] = pk2(f[0], f[1]); r[1] = pk2(f[2], f[3]); r[2] = pk2(f[4], f[5]); r[3] = pk2(f[6], f[7]); return r; }

constexpr int BM = 256, BK = 64, HALF = 128, HTB = HALF * BK * 2, NXCD = 8, WGM = 8;
DI int lds_byte(int r, int c) { const int st = (r >> 4) * 2 + (c >> 5), rr = r & 15, cc = c & 31, ob = rr * 64 + cc * 2; return st * 1024 + (ob ^ (((ob >> 9) & 1) << 5)); }
DI void stage_rc(int b, int& R, int& C) { const int st = b / 1024, sb = b % 1024, swz = sb ^ (((sb >> 9) & 1) << 5); R = (st >> 1) * 16 + swz / 64; C = (st & 1) * 32 + (swz % 64) / 2; }
DI int perm32(int rho) { const int n = rho >> 4, i = rho & 15; return 8 * (i >> 2) + 4 * n + (i & 3); }

DI bool unit_next(int i, int nM, int nN, int& pm, int& pn) {
    const int nwg = nM * nN; const long L = (long)i * gridDim.x + blockIdx.x; if (L >= nwg) return false;
    int wgid = (int)L; { const int q = nwg / NXCD, r = nwg % NXCD, xcd = wgid % NXCD, off = wgid / NXCD; wgid = (xcd < r ? xcd * (q + 1) : r * (q + 1) + (xcd - r) * q) + off; }
    const int nig = WGM * nN, gid = wgid / nig, fm = gid * WGM, gsz = (nM - fm) < WGM ? (nM - fm) : WGM;
    pm = fm + ((wgid % nig) % gsz); pn = (wgid % nig) / gsz; return true;
}

template <bool PERM, class Dec, class Epi>
DI void gemm_phase(LAS unsigned char* lds, const int nM, const int nN, const int K, const int lda, const int ldb, const Dec& dec, const Epi& epi, const int panel = -1) {
    const int tid = opq(threadIdx.x), wid = __builtin_amdgcn_readfirstlane(tid >> 6), lane = tid & 63, wr = wid >> 2, wc = wid & 3, fr = lane & 15, fq = lane >> 4;
    const int nt = K / BK;
    unsigned voffA[2], voffB[2];
#pragma unroll
    for (int i = 0; i < 2; ++i) { int R, C; stage_rc(tid * 16 + i * 8192, R, C); const int Rb = PERM ? ((R & ~31) + perm32(R & 31)) : R;
        voffA[i] = (unsigned)(R * lda + C) * 2u; voffB[i] = (unsigned)(Rb * ldb + C) * 2u; }
    const size_t kstep = (size_t)(BK * 2);
    const size_t hstepA = (size_t)HALF * lda * 2, hstepB = (size_t)HALF * ldb * 2;
    const unsigned ldsw = (unsigned)wid * 1024u;
    const int aoff = lds_byte(wr * 64 + fr, fq * 8), boff = lds_byte(wc * 32 + fr, fq * 8);
#define G_SA(b, h) (((b) * 2 + (h)) * HTB)
#define G_SB(b, h) ((4 + (b) * 2 + (h)) * HTB)
#define G_STAGE(bufoff, gbase, voff) do { _Pragma("unroll") for (int _i = 0; _i < 2; ++_i) \
        __builtin_amdgcn_global_load_lds((const unsigned*)((const char*)(gbase) + (voff)[_i]), (LAS unsigned*)(lds + (bufoff) + ldsw + _i * 8192), 16, 0, 0); } while (0)
#define G_LDA(dst, b, h) do { _Pragma("unroll") for (int m = 0; m < 4; ++m) _Pragma("unroll") for (int k = 0; k < 2; ++k) dst[m][k] = *(const LAS bf16x8*)(lds + G_SA(b, h) + aoff + m * 2048 + k * 1024); } while (0)
#define G_LDB(dst, b, h) do { _Pragma("unroll") for (int n = 0; n < 2; ++n) _Pragma("unroll") for (int k = 0; k < 2; ++k) dst[n][k] = *(const LAS bf16x8*)(lds + G_SB(b, h) + boff + n * 2048 + k * 1024); } while (0)
#define G_MMA(ai, bj, At, Bt) do { __builtin_amdgcn_s_setprio(1); _Pragma("unroll") for (int m = 0; m < 4; ++m) _Pragma("unroll") for (int n = 0; n < 2; ++n) _Pragma("unroll") for (int k = 0; k < 2; ++k) \
        acc[ai][bj][m][n] = __builtin_amdgcn_mfma_f32_16x16x32_bf16(Bt[n][k], At[m][k], acc[ai][bj][m][n], 0, 0, 0); __builtin_amdgcn_s_setprio(0); } while (0)
#define G_WAIT_V(n) asm volatile("s_waitcnt vmcnt(" #n ")" ::: "memory")
#define G_WAIT_L(n) asm volatile("s_waitcnt lgkmcnt(" #n ")" ::: "memory")
#define G_BAR __builtin_amdgcn_s_barrier()
#define G_SCHED __builtin_amdgcn_sched_barrier(0)
    int cpm, cpn, npm, npn, ui = 0;
    if (panel >= 0) { cpm = panel; cpn = 0; } else if (!unit_next(0, nM, nN, cpm, cpn)) return;
    f32x4 acc[2][2][4][2];
#pragma unroll
    for (int a = 0; a < 2; ++a)
#pragma unroll
        for (int b = 0; b < 2; ++b)
#pragma unroll
            for (int m = 0; m < 4; ++m)
#pragma unroll
                for (int n = 0; n < 2; ++n) acc[a][b][m][n] = (f32x4){0.f, 0.f, 0.f, 0.f};
    bf16x8 At[4][2], B0[2][2], B1[2][2];
    const char* cA; const char* cB; dec(cpm, cpn, cA, cB);
    G_STAGE(G_SB(0, 0), cB, voffB); G_STAGE(G_SA(0, 0), cA, voffA); G_STAGE(G_SB(0, 1), cB + hstepB, voffB); G_STAGE(G_SA(0, 1), cA + hstepA, voffA);
    if (wr == 1) G_BAR;
    G_WAIT_V(4); G_BAR;
    G_STAGE(G_SB(1, 0), cB + kstep, voffB); G_STAGE(G_SA(1, 0), cA + kstep, voffA); G_STAGE(G_SB(1, 1), cB + hstepB + kstep, voffB);
    G_WAIT_V(6); G_BAR;
    for (;;) {
        bool has_next;
        if (panel >= 0) { has_next = (ui + 1 < nN); npm = panel; npn = ui + 1; } else has_next = unit_next(ui + 1, nM, nN, npm, npn);
        const char* nA = cA; const char* nB = cB; if (has_next) dec(npm, npn, nA, nB);
#pragma nounroll
        for (int t = 0; t < nt; t += 2) {
            const bool last = (t == nt - 2);
            const char* a1 = cA + (size_t)(t + 1) * kstep;
            const char* a2 = last ? nA : cA + (size_t)(t + 2) * kstep; const char* b2 = last ? nB : cB + (size_t)(t + 2) * kstep;
            const char* a3 = a2 + kstep; const char* b3 = b2 + kstep;
            G_LDB(B0, 0, 0); G_SCHED; G_LDA(At, 0, 0); G_STAGE(G_SA(1, 1), a1 + hstepA, voffA);
            G_WAIT_L(8); G_BAR; G_WAIT_L(0); G_MMA(0, 0, At, B0); G_BAR; G_SCHED;
            G_LDB(B1, 0, 1); G_STAGE(G_SB(0, 0), b2, voffB);
            G_BAR; G_WAIT_L(0); G_MMA(0, 1, At, B1); G_BAR;
            G_LDA(At, 0, 1); G_STAGE(G_SA(0, 0), a2, voffA);
            G_BAR; G_WAIT_L(0); G_MMA(1, 0, At, B0); G_BAR; G_SCHED;
            G_STAGE(G_SB(0, 1), b2 + hstepB, voffB);
            G_WAIT_V(6); G_BAR; G_MMA(1, 1, At, B1); G_BAR;
            G_LDB(B0, 1, 0); G_SCHED; G_LDA(At, 1, 0); G_STAGE(G_SA(0, 1), a2 + hstepA, voffA);
            G_WAIT_L(8); G_BAR; G_WAIT_L(0); G_MMA(0, 0, At, B0); G_BAR; G_SCHED;
            G_LDB(B1, 1, 1); G_STAGE(G_SB(1, 0), b3, voffB);
            G_BAR; G_WAIT_L(0); G_MMA(0, 1, At, B1); G_BAR;
            G_LDA(At, 1, 1); G_STAGE(G_SA(1, 0), a3, voffA);
            G_BAR; G_WAIT_L(0); G_MMA(1, 0, At, B0); G_BAR; G_SCHED;
            G_STAGE(G_SB(1, 1), b3 + hstepB, voffB);
            G_WAIT_V(6); G_BAR; G_MMA(1, 1, At, B1); G_BAR;
        }
        epi(acc, cpm, cpn, wr, wc, fr, fq);
        if (!has_next) break;
#pragma unroll
        for (int a = 0; a < 2; ++a)
#pragma unroll
            for (int b = 0; b < 2; ++b)
#pragma unroll
                for (int m = 0; m < 4; ++m)
#pragma unroll
                    for (int n = 0; n < 2; ++n) acc[a][b][m][n] = (f32x4){0.f, 0.f, 0.f, 0.f};
        cpm = npm; cpn = npn; cA = nA; cB = nB; ++ui;
    }
    G_WAIT_V(0);
    if (wr == 0) G_BAR;
    G_BAR;
#undef G_SA
#undef G_SB
#undef G_STAGE
#undef G_LDA
#undef G_LDB
#undef G_MMA
#undef G_WAIT_V
#undef G_WAIT_L
#undef G_BAR
#undef G_SCHED
}

template <int ACT>
DI void epi_bf16(const f32x4 (&acc)[2][2][4][2], bf16_t* O, const int ldc, int wr, int wc, int fr, int fq, const float* ssrow = nullptr) {
#pragma unroll
    for (int ai = 0; ai < 2; ++ai)
#pragma unroll
        for (int m = 0; m < 4; ++m) {
            bf16_t* rowp = O + (size_t)(ai * HALF + wr * 64 + m * 16 + fr) * ldc + wc * 32 + 8 * fq;
            const float rsc = ssrow ? __builtin_amdgcn_rsqf(ssrow[ai * HALF + wr * 64 + m * 16 + fr] * (1.f / 1024.f) + EPS_) : 1.f;
#pragma unroll
            for (int bj = 0; bj < 2; ++bj) {
                f32x4 v0 = acc[ai][bj][m][0] * rsc, v1 = acc[ai][bj][m][1] * rsc;
                if (ACT == 1) {
#pragma unroll
                    for (int j = 0; j < 4; ++j) { v0[j] = silu_(v0[j]); v1[j] = silu_(v1[j]); } }
                if (ACT == 2) {
#pragma unroll
                    for (int j = 0; j < 4; ++j) { v0[j] = sigm(v0[j]); v1[j] = sigm(v1[j]); } }
                u32x4 w; w[0] = pk2(v0[0], v0[1]); w[1] = pk2(v0[2], v0[3]); w[2] = pk2(v1[0], v1[1]); w[3] = pk2(v1[2], v1[3]);
                *(u32x4*)(rowp + bj * HALF) = w;
            }
        }
}

struct TJob { const float* src; bf16_t* dst; int lds_, srcb, K, N, ldd, dstb; float scale; const float* ks; };
DI TJob get_job(const Params& p, int j) {
    TJob t; unsigned char* ws = p.ws;
    switch (j) {
    case 0: t = TJob{p.in[3], (bf16_t*)(ws + WS_WT_XM), 6152, 0, 1024, 2048, 1024, 0, 1.f, nullptr}; break;
    case 1: t = TJob{p.in[3] + 2048, (bf16_t*)(ws + WS_WT_ZO), 6152, 0, 1024, 4096, 1024, 0, 1.f, nullptr}; break;
    case 2: t = TJob{p.in[6], (bf16_t*)(ws + WS_WT_QK), 256, 512 * 256, 512, 256, 512, 512 * 512, 0.0625f, nullptr}; break;
    case 3: t = TJob{p.in[7], (bf16_t*)(ws + WS_WT_QK) + 256 * 512, 256, 512 * 256, 512, 256, 512, 512 * 512, 1.f, nullptr}; break;
    case 4: t = TJob{p.in[8], (bf16_t*)(ws + WS_WT_V), 512, 512 * 512, 512, 512, 512, 512 * 512, 1.f, nullptr}; break;
    case 5: t = TJob{p.in[13], (bf16_t*)(ws + WS_WT_OUT0), 1024, 0, 2048, 1024, 2048, 0, 1.f, nullptr}; break;
    case 6: t = TJob{p.in[14], (bf16_t*)(ws + WS_WT_IN1), 3072, 0, 1024, 3072, 1024, 0, 1.f, p.in[1] + 1024}; break;
    default: t = TJob{p.in[22], (bf16_t*)(ws + WS_WT_OUT1), 1024, 0, 1536, 1024, 1536, 0, 1.f, nullptr}; break;
    }
    return t;
}

template <bool GATES>
DI void rmsnorm_rows(const float* X, const float* g, bf16_t* U, const float* Wg, const float* b_i, const float* b_f, float* LI, float* LF) {
    const int tid_ = opq(threadIdx.x), lane = tid_ & 63, wid = tid_ >> 6;
    const int gw = blockIdx.x * 8 + wid, nw = gridDim.x * 8;
    f32x4 g4[4];
#pragma unroll
    for (int i = 0; i < 4; ++i) g4[i] = ((const f32x4*)g)[lane + 64 * i];
    f32x4 nx[4];
#pragma unroll
    for (int i = 0; i < 4; ++i) nx[i] = ((const f32x4*)(X + (size_t)gw * 1024))[lane + 64 * i];
    for (int row = gw; row < T_; row += nw) {
        f32x4 v[4]; float ss = 0.f;
        const int rown = (row + nw < T_) ? row + nw : row;
#pragma unroll
        for (int i = 0; i < 4; ++i) { v[i] = nx[i]; nx[i] = ((const f32x4*)(X + (size_t)rown * 1024))[lane + 64 * i]; ss += v[i][0] * v[i][0] + v[i][1] * v[i][1] + v[i][2] * v[i][2] + v[i][3] * v[i][3]; }
        ss = wave_sum(ss);
        const float rs = __builtin_amdgcn_rsqf(ss * (1.f / 1024.f) + EPS_);
#pragma unroll
        for (int i = 0; i < 4; ++i) { v[i] = v[i] * rs * g4[i]; u32x2 w; w[0] = pk2(v[i][0], v[i][1]); w[1] = pk2(v[i][2], v[i][3]); ((u32x2*)(U + (size_t)row * 1024))[lane + 64 * i] = w; }
        if (GATES) {
            float d[8];
#pragma unroll
            for (int j = 0; j < 8; ++j) { float s = 0.f;
#pragma unroll
                for (int i = 0; i < 4; ++i) { const f32x4 w = ((const f32x4*)(Wg + j * 1024))[lane + 64 * i]; s += v[i][0] * w[0] + v[i][1] * w[1] + v[i][2] * w[2] + v[i][3] * w[3]; }
                d[j] = wave_sum(s); }
            float val = d[0];
#pragma unroll
            for (int j = 1; j < 8; ++j) val = (lane == j) ? d[j] : val;
            if (lane < 8) {
                const int b = row >> 11, s = row & 2047, hh = lane & 3;
                if (lane < 4) LI[(size_t)(b * 4 + hh) * S_ + s] = val + b_i[hh];
                else { const float xx = val + b_f[hh]; LF[(size_t)(b * 4 + hh) * S_ + s] = fminf(xx, 0.f) - log1pf(__expf(-fabsf(xx))); }
            }
        }
    }
}

DI void phase_prep(const Params& p, unsigned char* shm) {
    const int tid = opq(threadIdx.x);
    const size_t gtid = (size_t)blockIdx.x * 512 + tid, gsize = (size_t)gridDim.x * 512;
    float* tl = (float*)shm;
    float* Wg = (float*)(shm + 20480);
    for (int idx = tid; idx < 8192; idx += 512) { const int j = idx >> 10, k = idx & 1023; Wg[idx] = p.in[3][(size_t)k * 6152 + 6144 + j]; }
    for (int tile = blockIdx.x; tile < 3712; tile += gridDim.x) {
        int j, base;
        if (tile < 512) { j = 0; base = 0; } else if (tile < 1536) { j = 1; base = 512; } else if (tile < 1664) { j = 2; base = 1536; } else if (tile < 1792) { j = 3; base = 1664; }
        else if (tile < 2048) { j = 4; base = 1792; } else if (tile < 2560) { j = 5; base = 2048; } else if (tile < 3328) { j = 6; base = 2560; } else { j = 7; base = 3328; }
        const TJob jb = get_job(p, j);
        const int lt = tile - base, ntn = jb.N / 64, ntk = jb.K / 64;
        const int b = lt / (ntn * ntk), r = lt % (ntn * ntk), tk = r / ntn, tn = r % ntn;
        const float* src = jb.src + (size_t)b * jb.srcb + (size_t)(tk * 64) * jb.lds_ + tn * 64;
#pragma unroll
        for (int i = 0; i < 2; ++i) { const int kk = (tid >> 4) + 32 * i, c4 = (tid & 15) * 4; const f32x4 v = *(const f32x4*)(src + (size_t)kk * jb.lds_ + c4);
            const float sc = jb.ks ? jb.scale * jb.ks[tk * 64 + kk] : jb.scale;
            tl[kk * 65 + c4] = v[0] * sc; tl[kk * 65 + c4 + 1] = v[1] * sc; tl[kk * 65 + c4 + 2] = v[2] * sc; tl[kk * 65 + c4 + 3] = v[3] * sc; }
        __syncthreads();
        { const int n = tid >> 3, k8 = (tid & 7) * 8; float f[8];
#pragma unroll
          for (int e = 0; e < 8; ++e) f[e] = tl[(k8 + e) * 65 + n];
          *(u32x4*)(jb.dst + (size_t)b * jb.dstb + (size_t)(tn * 64 + n) * jb.ldd + tk * 64 + k8) = pack8f(f); }
        __syncthreads();
    }
    { bf16_t* WG = (bf16_t*)(p.ws + WS_WT_G);
      for (size_t idx = gtid; idx < (size_t)8 * 2 * 192 * 192; idx += gsize) {
          const int c = (int)(idx % 192), d = (int)((idx / 192) % 192), g = (int)((idx / 36864) & 1), blk = (int)(idx / 73728);
          const float v = (g ? p.in[19] : p.in[17])[(size_t)blk * 36864 + (size_t)c * 192 + d];
          WG[idx] = (bf16_t)(pk2(v, 0.f) & 0xffffu); } }
    { float* SS = (float*)(p.ws + WS_SS); float* SS1 = (float*)(p.ws + WS_SS1); for (size_t idx = gtid; idx < (size_t)T_; idx += gsize) { SS[idx] = 0.f; SS1[idx] = 0.f; } }
    { float* SP = (float*)(p.ws + WS_SP); for (size_t idx = gtid; idx < (size_t)1536; idx += gsize) SP[idx] = -8.f * log1pf(__expf(-p.in[21][idx])); }
    __syncthreads();
    rmsnorm_rows<true>(p.in[0], p.in[1], (bf16_t*)(p.ws + WS_U), Wg, p.in[9], p.in[10], (float*)(p.ws + WS_LI), (float*)(p.ws + WS_LF));
}

template <int CIN, int COUT, bool SILU>
DI void conv_phase(const bf16_t* X, const float* w, const float* bias, bf16_t* Y) {
    constexpr int NG = COUT / 8, NGV = CIN / 8;
    const int total = (T_ / 16) * NG;
    for (int it = blockIdx.x * 512 + opq(threadIdx.x); it < total; it += gridDim.x * 512) {
        const int cgp = it % NG, tc = it / NG, t0 = tc * 16;
        if (cgp >= NGV) {
            for (int r = 0; r < 16; ++r) *(u32x4*)(Y + (size_t)(t0 + r) * COUT + cgp * 8) = (u32x4){0u, 0u, 0u, 0u};
            continue;
        }
        const int c0 = cgp * 8;
        float w0[8], w1[8], w2[8], w3[8], bb[8], p3[8], p2[8], p1[8];
#pragma unroll
        for (int e = 0; e < 8; ++e) { w0[e] = w[c0 + e]; w1[e] = w[CIN + c0 + e]; w2[e] = w[2 * CIN + c0 + e]; w3[e] = w[3 * CIN + c0 + e]; bb[e] = bias[c0 + e]; }
        if ((t0 & 2047) == 0) {
#pragma unroll
            for (int e = 0; e < 8; ++e) { p3[e] = 0.f; p2[e] = 0.f; p1[e] = 0.f; }
        } else {
            unpack8(*(const u32x4*)(X + (size_t)(t0 - 3) * CIN + c0), p3);
            unpack8(*(const u32x4*)(X + (size_t)(t0 - 2) * CIN + c0), p2);
            unpack8(*(const u32x4*)(X + (size_t)(t0 - 1) * CIN + c0), p1);
        }
#pragma unroll
        for (int r = 0; r < 16; ++r) {
            float cur[8], y[8];
            unpack8(*(const u32x4*)(X + (size_t)(t0 + r) * CIN + c0), cur);
#pragma unroll
            for (int e = 0; e < 8; ++e) { float v = bb[e] + w0[e] * p3[e] + w1[e] * p2[e] + w2[e] * p1[e] + w3[e] * cur[e]; y[e] = SILU ? silu_(v) : v; p3[e] = p2[e]; p2[e] = p1[e]; p1[e] = cur[e]; }
            *(u32x4*)(Y + (size_t)(t0 + r) * COUT + c0) = pack8f(y);
        }
    }
}

DI void conv0_phase(const bf16_t* X, const float* w, const float* bias, bf16_t* Y) {
    const int gt = blockIdx.x * 512 + opq(threadIdx.x), stride = gridDim.x * 512;
    const int c0 = (gt & 255) * 8;
    float w0[8], w1[8], w2[8], w3[8], bb[8];
#pragma unroll
    for (int e = 0; e < 8; ++e) { w0[e] = w[c0 + e]; w1[e] = w[2048 + c0 + e]; w2[e] = w[4096 + c0 + e]; w3[e] = w[6144 + c0 + e]; bb[e] = bias[c0 + e]; }
    const int total = (T_ / 16) * 256;
    u32x4 nx[19];
    if (gt < total) {
        const int t0 = (gt >> 8) * 16; const bool first = (t0 & 2047) == 0;
#pragma unroll
        for (int r = 0; r < 19; ++r) { const int t = (first && r < 3) ? t0 : t0 - 3 + r; nx[r] = *(const u32x4*)(X + (size_t)t * 2048 + c0); }
    }
    for (int it = gt; it < total; it += stride) {
        const int t0 = (it >> 8) * 16; const bool first = (t0 & 2047) == 0;
        u32x4 cu[19];
#pragma unroll
        for (int r = 0; r < 19; ++r) cu[r] = nx[r];
        if (it + stride < total) {
            const int t1 = ((it + stride) >> 8) * 16; const bool f1 = (t1 & 2047) == 0;
#pragma unroll
            for (int r = 0; r < 19; ++r) { const int t = (f1 && r < 3) ? t1 : t1 - 3 + r; nx[r] = *(const u32x4*)(X + (size_t)t * 2048 + c0); }
        }
        float p3[8], p2[8], p1[8];
        unpack8(cu[0], p3); unpack8(cu[1], p2); unpack8(cu[2], p1);
        if (first) {
#pragma unroll
            for (int e = 0; e < 8; ++e) { p3[e] = 0.f; p2[e] = 0.f; p1[e] = 0.f; }
        }
#pragma unroll
        for (int r = 0; r < 16; ++r) {
            float cur[8], y[8];
            unpack8(cu[3 + r], cur);
#pragma unroll
            for (int e = 0; e < 8; ++e) { const float v = bb[e] + w0[e] * p3[e] + w1[e] * p2[e] + w2[e] * p1[e] + w3[e] * cur[e]; y[e] = silu_(v); p3[e] = p2[e]; p2[e] = p1[e]; p1[e] = cur[e]; }
            *(u32x4*)(Y + (size_t)(t0 + r) * 2048 + c0) = pack8f(y);
        }
    }
}

DI void gate_scan(const Params& p) {
    const int tid_ = opq(threadIdx.x), lane = tid_ & 63, wid = tid_ >> 6;
    const int bh = blockIdx.x * 8 + wid;
    if (bh >= 128) return;
    const float* LI = (const float*)(p.ws + WS_LI); const float* LF = (const float*)(p.ws + WS_LF);
    float* GP = (float*)(p.ws + WS_GP); float* GQ = (float*)(p.ws + WS_GQ); float* GD = (float*)(p.ws + WS_GD); float* GF = (float*)(p.ws + WS_GF); float* GW = (float*)(p.ws + WS_GW);
    float mcar = 0.f;
    float lfn = LF[(size_t)bh * S_ + lane], lin = LI[(size_t)bh * S_ + lane];
    for (int c = 0; c < 32; ++c) {
        const size_t o = (size_t)bh * S_ + c * 64 + lane;
        const float lf = lfn, li = lin;
        { const size_t on = (c < 31) ? o + 64 : o; lfn = LF[on]; lin = LI[on]; }
        float F = lf;
        F += __int_as_float(__builtin_amdgcn_update_dpp(0, __float_as_int(F), 0x111, 0xf, 0xf, false));
        F += __int_as_float(__builtin_amdgcn_update_dpp(0, __float_as_int(F), 0x112, 0xf, 0xf, false));
        F += __int_as_float(__builtin_amdgcn_update_dpp(0, __float_as_int(F), 0x114, 0xf, 0xf, false));
        F += __int_as_float(__builtin_amdgcn_update_dpp(0, __float_as_int(F), 0x118, 0xf, 0xf, false));
        { const int fi = __float_as_int(F); const float t0 = __int_as_float(__builtin_amdgcn_readlane(fi, 15)), t1 = __int_as_float(__builtin_amdgcn_readlane(fi, 31)), t2 = __int_as_float(__builtin_amdgcn_readlane(fi, 47));
          const int rw = lane >> 4; F += (rw >= 1 ? t0 : 0.f) + (rw >= 2 ? t1 : 0.f) + (rw >= 3 ? t2 : 0.f); }
        const float Qs = li - F;
        float Mx = Qs;
        { const int ninf = __float_as_int(-__builtin_inff());
          Mx = fmaxf(Mx, __int_as_float(__builtin_amdgcn_update_dpp(ninf, __float_as_int(Mx), 0x111, 0xf, 0xf, false)));
          Mx = fmaxf(Mx, __int_as_float(__builtin_amdgcn_update_dpp(ninf, __float_as_int(Mx), 0x112, 0xf, 0xf, false)));
          Mx = fmaxf(Mx, __int_as_float(__builtin_amdgcn_update_dpp(ninf, __float_as_int(Mx), 0x114, 0xf, 0xf, false)));
          Mx = fmaxf(Mx, __int_as_float(__builtin_amdgcn_update_dpp(ninf, __float_as_int(Mx), 0x118, 0xf, 0xf, false)));
          const int mi = __float_as_int(Mx); const float t0 = __int_as_float(__builtin_amdgcn_readlane(mi, 15)), t1 = __int_as_float(__builtin_amdgcn_readlane(mi, 31)), t2 = __int_as_float(__builtin_amdgcn_readlane(mi, 47));
          const int rw = lane >> 4; const float ninff = -__builtin_inff();
          Mx = fmaxf(Mx, fmaxf(fmaxf(rw >= 1 ? t0 : ninff, rw >= 2 ? t1 : ninff), rw >= 3 ? t2 : ninff)); }
        const float a = F + mcar, mt = fmaxf(a, F + Mx);
        const float P = F - mt;
        const float P63 = __int_as_float(__builtin_amdgcn_readlane(__float_as_int(P), 63));
        GP[o] = P; GQ[o] = Qs; GD[o] = __expf(a - mt); GF[o] = __expf(-mt); GW[o] = __expf(P63 + Qs);
        mcar = __int_as_float(__builtin_amdgcn_readlane(__float_as_int(mt), 63));
    }
}

template <int ST> DI bf16x8 pack_step(const f32x16& x) {
    u32x4 r; r[0] = pk2(x[8 * ST], x[8 * ST + 1]); r[1] = pk2(x[8 * ST + 2], x[8 * ST + 3]); r[2] = pk2(x[8 * ST + 4], x[8 * ST + 5]); r[3] = pk2(x[8 * ST + 6], x[8 * ST + 7]);
    return __builtin_bit_cast(bf16x8, r);
}
DI bf16x8 join4(const s16x4& lo, const s16x4& hi) { return __builtin_shufflevector(lo, hi, 0, 1, 2, 3, 4, 5, 6, 7); }
#define MFMA32(a, b, c) __builtin_amdgcn_mfma_f32_32x32x16_bf16((a), (b), (c), 0, 0, 0)
#define TRRD(ptr) __builtin_amdgcn_ds_read_tr16_b64_v4i16((LAS s16x4*)(ptr))

DI void phase_mlstm(const Params& p, unsigned char* shm) {
    LAS unsigned char* lds = (LAS unsigned char*)shm;
    constexpr int RS = 528, QI = 0, KI = 64 * RS, VI = KI + 80 * RS, SMI = VI + 64 * RS, SMS = 144;
    constexpr int NS = SMI + 64 * SMS, NACC = NS + 1024, QN = NACC + 1024, RSUM = QN + 256, PC = RSUM + 256, QC = PC + 256, DEC = QC + 256, FLR = DEC + 256, WL = FLR + 256;
    constexpr int PNB = WL + 256;
    static_assert(PNB + 16384 <= LDS_BYTES - 64, "lds");
    const int w = __builtin_amdgcn_readfirstlane(threadIdx.x >> 6);
    const bf16_t* Q = (const bf16_t*)p.out; const bf16_t* Kp = Q + (size_t)T_ * 1024; const bf16_t* V = (const bf16_t*)(p.ws + WS_RC);
    bf16_t* H = (bf16_t*)(p.ws + WS_RA);
    const float* GP = (const float*)(p.ws + WS_GP); const float* GQ = (const float*)(p.ws + WS_GQ); const float* GD = (const float*)(p.ws + WS_GD);
    const float* GF = (const float*)(p.ws + WS_GF); const float* GW = (const float*)(p.ws + WS_GW);
    LAS float* n_s = (LAS float*)(lds + NS); LAS float* nacc = (LAS float*)(lds + NACC); LAS float* qn = (LAS float*)(lds + QN); LAS float* rsum = (LAS float*)(lds + RSUM);
    LAS float* wls = (LAS float*)(lds + WL);
    LAS float* Pc = (LAS float*)(lds + PC); LAS float* Qc = (LAS float*)(lds + QC); LAS float* dec = (LAS float*)(lds + DEC); LAS float* flr = (LAS float*)(lds + FLR);
    for (int unit = blockIdx.x; unit < 256; unit += gridDim.x) {
        const int bh = (unit & 7) * 16 + (unit >> 4), half = (unit >> 3) & 1, b = bh >> 2, h = bh & 3;
        f32x16 C[8];
        unsigned pf0 = 0u, pf1 = 0u;
#pragma unroll
        for (int i = 0; i < 8; ++i)
#pragma unroll
            for (int e = 0; e < 16; ++e) C[i][e] = 0.f;
        if (threadIdx.x < 256) { n_s[threadIdx.x] = 0.f; nacc[threadIdx.x] = 0.f; }
        { const int tid = threadIdx.x; if (tid < 480) *(LAS u32x4*)(lds + KI + (65 + (tid >> 5)) * RS + 16 * (tid & 31)) = (u32x4){0u, 0u, 0u, 0u}; }
        for (int c = 0; c < 32; ++c) {
            __syncthreads();
            asm volatile("" :: "v"(pf0), "v"(pf1));
            const int t0 = b * S_ + c * 64; const size_t gbase = (size_t)bh * S_ + c * 64;
            {
                const int tid = opq(threadIdx.x), r4 = tid >> 5, cgp = tid & 31;
                if (tid < 64) { Pc[tid] = GP[gbase + tid]; Qc[tid] = GQ[gbase + tid]; dec[tid] = GD[gbase + tid]; flr[tid] = GF[gbase + tid]; wls[tid] = GW[gbase + tid]; rsum[tid] = 0.f; }
                float pn[8];
#pragma unroll
                for (int e = 0; e < 8; ++e) pn[e] = 0.f;
                if (tid < 32) {
                    const f32x4 n0 = *(const LAS f32x4*)(n_s + 8 * cgp), n1 = *(const LAS f32x4*)(n_s + 8 * cgp + 4);
                    u32x4 nb; nb[0] = pk2(n0[0], n0[1]); nb[1] = pk2(n0[2], n0[3]); nb[2] = pk2(n1[0], n1[1]); nb[3] = pk2(n1[2], n1[3]);
                    *(LAS u32x4*)(lds + KI + 64 * RS + 16 * cgp) = nb;
                }
                const bf16_t* qp = Q + (size_t)(t0 + r4) * 1024 + h * 256 + 8 * cgp;
                const bf16_t* kp = Kp + (size_t)(t0 + r4) * 1024 + h * 256 + 8 * cgp;
                const bf16_t* vp = V + (size_t)(t0 + r4) * 2048 + h * 512 + half * 256 + 8 * cgp;
                const int lo_ = r4 * RS + 16 * cgp;
#pragma unroll
                for (int i = 0; i < 4; ++i) {
                    const u32x4 qv = *(const u32x4*)(qp + (size_t)i * 16 * 1024);
                    const u32x4 kv = *(const u32x4*)(kp + (size_t)i * 16 * 1024);
                    const u32x4 vv = *(const u32x4*)(vp + (size_t)i * 16 * 2048);
                    const float wl = GW[gbase + r4 + 16 * i];
                    *(LAS u32x4*)(lds + QI + lo_ + i * 16 * RS) = qv;
                    *(LAS u32x4*)(lds + KI + lo_ + i * 16 * RS) = kv;
                    *(LAS u32x4*)(lds + VI + lo_ + i * 16 * RS) = vv;
                    float f[8];
                    unpack8(kv, f);
#pragma unroll
                    for (int e = 0; e < 8; ++e) pn[e] += wl * f[e];
                }
                *(LAS f32x4*)(lds + PNB + r4 * 1024 + cgp * 32) = (f32x4){pn[0], pn[1], pn[2], pn[3]};
                *(LAS f32x4*)(lds + PNB + r4 * 1024 + cgp * 32 + 16) = (f32x4){pn[4], pn[5], pn[6], pn[7]};
            }
            __syncthreads();
            if (c < 31) {
                const int tid = opq(threadIdx.x), rr = (tid & 255) >> 2, sg = tid & 3;
                const bf16_t* qk = (tid < 256 ? Q : Kp) + (size_t)(t0 + 64 + rr) * 1024 + h * 256 + sg * 64;
                pf0 = *(const unsigned*)qk;
                if (tid < 256) pf1 = *(const unsigned*)(V + (size_t)(t0 + 64 + rr) * 2048 + h * 512 + half * 256 + sg * 64);
            }
            const float d_last = dec[63];
            if (threadIdx.x < 256) { const int tid = threadIdx.x; float a = 0.f;
#pragma unroll
                for (int g = 0; g < 16; ++g) a += *(const LAS float*)(lds + PNB + g * 1024 + tid * 4);
                n_s[tid] = d_last * n_s[tid] + a; }
            {
                const int lane = opq(threadIdx.x) & 63, fr = lane & 15, fq = lane >> 4;
                const int ti = w & 3;
#pragma unroll
                for (int z = 0; z < 2; ++z) {
                    const int si = 2 * (w >> 2) + z;
                    f32x4 a4 = {0.f, 0.f, 0.f, 0.f};
                    if (si <= ti) {
                        const int ka = KI + (16 * si + fr) * RS + 16 * fq, qa = QI + (16 * ti + fr) * RS + 16 * fq;
#pragma unroll
                        for (int kk = 0; kk < 8; ++kk) {
                            const bf16x8 af = *(const LAS bf16x8*)(lds + ka + 64 * kk);
                            const bf16x8 bq = *(const LAS bf16x8*)(lds + qa + 64 * kk);
                            a4 = __builtin_amdgcn_mfma_f32_16x16x32_bf16(af, bq, a4, 0, 0, 0);
                        }
                        const int t = 16 * ti + fr; const float Pt = Pc[t];
                        const f32x4 qs = *(const LAS f32x4*)(Qc + 16 * si + 4 * fq);
                        float rsm = 0.f;
#pragma unroll
                        for (int j = 0; j < 4; ++j) { const int s = 16 * si + 4 * fq + j; const float wg = (s <= t) ? __expf(Pt + qs[j]) : 0.f; a4[j] *= wg; rsm += a4[j]; }
                        rsm += __shfl_xor(rsm, 16); rsm += __shfl_xor(rsm, 32);
                        if (fq == 0) __hip_atomic_fetch_add((float*)(shm + RSUM) + t, rsm, __ATOMIC_RELAXED, __HIP_MEMORY_SCOPE_WORKGROUP);
                    }
                    u32x2 sm; sm[0] = pk2(a4[0], a4[1]); sm[1] = pk2(a4[2], a4[3]);
                    *(LAS u32x2*)(lds + SMI + (16 * ti + fr) * SMS + (16 * si + 4 * fq) * 2) = sm;
                }
                if (w == 4 || w == 5) {
#pragma unroll
                    for (int z = 0; z < 2; ++z) {
                        const int tn = 2 * (w - 4) + z;
                        const int ka = KI + (64 + fr) * RS + 16 * fq, qa = QI + (16 * tn + fr) * RS + 16 * fq;
                        f32x4 a4 = {0.f, 0.f, 0.f, 0.f};
#pragma unroll
                        for (int kk = 0; kk < 8; ++kk) {
                            const bf16x8 af = *(const LAS bf16x8*)(lds + ka + 64 * kk);
                            const bf16x8 bq = *(const LAS bf16x8*)(lds + qa + 64 * kk);
                            a4 = __builtin_amdgcn_mfma_f32_16x16x32_bf16(af, bq, a4, 0, 0, 0);
                        }
                        if (fq == 0) qn[16 * tn + fr] = a4[0];
                    }
                }
            }
            __builtin_amdgcn_sched_barrier(0);
            f32x16 acc2[2];
#pragma unroll
            for (int m = 0; m < 2; ++m)
#pragma unroll
                for (int e = 0; e < 16; ++e) acc2[m][e] = 0.f;
            {
                const int lane = opq(threadIdx.x) & 63, l32 = lane & 31, hh = lane >> 5;
                const int qb = QI + l32 * RS + 8 * hh;
#pragma unroll
                for (int ci = 0; ci < 8; ++ci) {
                    s16x4 lo[2][2], hi[2][2];
#pragma unroll
                    for (int st = 0; st < 2; ++st)
#pragma unroll
                        for (int m2 = 0; m2 < 2; ++m2) { const int off = qb + 32 * m2 * RS + 64 * ci + 32 * st;
                            lo[st][m2] = *(const LAS s16x4*)(lds + off); hi[st][m2] = *(const LAS s16x4*)(lds + off + 16); }
                    const bf16x8 bf0 = pack_step<0>(C[ci]), bf1 = pack_step<1>(C[ci]);
                    __builtin_amdgcn_sched_barrier(0);
                    __builtin_amdgcn_s_setprio(1);
#pragma unroll
                    for (int m2 = 0; m2 < 2; ++m2) acc2[m2] = MFMA32(join4(lo[0][m2], hi[0][m2]), bf0, acc2[m2]);
#pragma unroll
                    for (int m2 = 0; m2 < 2; ++m2) acc2[m2] = MFMA32(join4(lo[1][m2], hi[1][m2]), bf1, acc2[m2]);
                    __builtin_amdgcn_s_setprio(0);
                    __builtin_amdgcn_sched_barrier(0);
                }
            }
            __syncthreads();
            {
                const int lane = opq(threadIdx.x) & 63, l32 = lane & 31, hh = lane >> 5, q4 = (lane & 15) >> 2, p4 = lane & 3, blk = (lane >> 4) & 1;
#pragma unroll
                for (int m = 0; m < 2; ++m)
#pragma unroll
                    for (int g = 0; g < 4; ++g) { const f32x4 d4 = *(const LAS f32x4*)(dec + 32 * m + 8 * g + 4 * hh);
#pragma unroll
                        for (int e = 0; e < 4; ++e) acc2[m][4 * g + e] *= d4[e]; }
                const int vb = VI + (8 * hh + q4) * RS + (32 * w + 16 * blk) * 2 + 8 * p4, sb = SMI + l32 * SMS + 16 * hh;
#pragma unroll
                for (int kk = 0; kk < 4; ++kk) {
                    const s16x4 lo = TRRD(lds + vb + 16 * kk * RS), hi = TRRD(lds + vb + 16 * kk * RS + 4 * RS);
                    const bf16x8 bf = join4(lo, hi);
#pragma unroll
                    for (int m = 0; m < 2; ++m) { const bf16x8 af = *(const LAS bf16x8*)(lds + sb + 32 * m * SMS + 32 * kk); acc2[m] = MFMA32(af, bf, acc2[m]); }
                }
                const int hb = QI + 4 * hh * RS + (32 * w + l32) * 2;
#pragma unroll
                for (int m = 0; m < 2; ++m)
#pragma unroll
                    for (int g = 0; g < 4; ++g) {
                        const int rb = 32 * m + 8 * g;
                        const f32x4 d4 = *(const LAS f32x4*)(dec + rb + 4 * hh), n4 = *(const LAS f32x4*)(qn + rb + 4 * hh), s4 = *(const LAS f32x4*)(rsum + rb + 4 * hh), f4 = *(const LAS f32x4*)(flr + rb + 4 * hh);
#pragma unroll
                        for (int e = 0; e < 4; ++e) {
                            const float den = d4[e] * n4[e] + s4[e];
                            const float val = acc2[m][4 * g + e] * __builtin_amdgcn_rcpf(fmaxf(fabsf(den), f4[e]));
                            *(LAS bf16_t*)(lds + hb + (rb + e) * RS) = (bf16_t)(pk2(val, 0.f) & 0xffffu);
                        }
                    }
            }
            __builtin_amdgcn_sched_barrier(0);
            {
                const int lane = opq(threadIdx.x) & 63, hh = lane >> 5, q4 = (lane & 15) >> 2, p4 = lane & 3, blk = (lane >> 4) & 1;
                const int tb = (8 * hh + q4) * RS + 32 * blk + 8 * p4;
                bf16x8 bw[4];
#pragma unroll
                for (int kk = 0; kk < 4; ++kk) { const int voff = VI + tb + 64 * w + 16 * kk * RS;
                    const bf16x8 raw = join4(TRRD(lds + voff), TRRD(lds + voff + 4 * RS));
                    const f32x4 w0 = *(const LAS f32x4*)(wls + 16 * kk + 8 * hh), w1 = *(const LAS f32x4*)(wls + 16 * kk + 8 * hh + 4);
                    float f[8]; unpack8(__builtin_bit_cast(u32x4, raw), f);
#pragma unroll
                    for (int e = 0; e < 4; ++e) { f[e] *= w0[e]; f[4 + e] *= w1[e]; }
                    bw[kk] = __builtin_bit_cast(bf16x8, pack8f(f)); }
#pragma unroll
                for (int ci = 0; ci < 8; ++ci) {
                    bf16x8 ka[4];
#pragma unroll
                    for (int kk = 0; kk < 4; ++kk) { const int koff = KI + tb + 64 * ci + 16 * kk * RS; ka[kk] = join4(TRRD(lds + koff), TRRD(lds + koff + 4 * RS)); }
#pragma unroll
                    for (int e = 0; e < 16; ++e) C[ci][e] *= d_last;
                    __builtin_amdgcn_sched_barrier(0);
                    __builtin_amdgcn_s_setprio(1);
#pragma unroll
                    for (int kk = 0; kk < 4; ++kk) C[ci] = MFMA32(ka[kk], bw[kk], C[ci]);
                    __builtin_amdgcn_s_setprio(0);
                    __builtin_amdgcn_sched_barrier(0);
                }
            }
            __syncthreads();
            {
                const int tid = opq(threadIdx.x), r4 = tid >> 5, cgp = tid & 31;
                bf16_t* hp = H + (size_t)(t0 + r4) * 2048 + h * 512 + half * 256 + 8 * cgp;
#pragma unroll
                for (int i = 0; i < 4; ++i) *(u32x4*)(hp + (size_t)i * 16 * 2048) = *(const LAS u32x4*)(lds + QI + (r4 + 16 * i) * RS + 16 * cgp);
            }
        }
        __syncthreads();
    }
}


DI void phase_post(const Params& p) {
    const int tid_ = opq(threadIdx.x), lane = tid_ & 63, wid = tid_ >> 6;
    const int gw = blockIdx.x * 8 + wid, nw = gridDim.x * 8;
    bf16_t* H = (bf16_t*)(p.ws + WS_RA); const bf16_t* O = (const bf16_t*)p.out; const bf16_t* XC = (const bf16_t*)(p.ws + WS_RB); const bf16_t* Z = (const bf16_t*)(p.ws + WS_RC);
    const float* nwp = p.in[11]; const float* skp = p.in[12];
    u32x4 nh, no, nx, nz;
    { const size_t b0 = (size_t)(gw >> 2) * 2048 + (gw & 3) * 512 + lane * 8; nh = *(const u32x4*)(H + b0); no = *(const u32x4*)(O + b0); nx = *(const u32x4*)(XC + b0); nz = *(const u32x4*)(Z + b0); }
    for (int u = gw; u < T_ * 4; u += nw) {
        const int hd = u & 3; const size_t base = (size_t)(u >> 2) * 2048 + hd * 512 + lane * 8;
        float hv[8], ov[8], xv[8], zv[8];
        unpack8(nh, hv); unpack8(no, ov); unpack8(nx, xv); unpack8(nz, zv);
        { const int un = (u + nw < T_ * 4) ? u + nw : u; const size_t bn = (size_t)(un >> 2) * 2048 + (un & 3) * 512 + lane * 8;
          nh = *(const u32x4*)(H + bn); no = *(const u32x4*)(O + bn); nx = *(const u32x4*)(XC + bn); nz = *(const u32x4*)(Z + bn); }
        float s = 0.f;
#pragma unroll
        for (int e = 0; e < 8; ++e) { hv[e] *= sigm(ov[e]); s += hv[e]; }
        const float mu = wave_sum(s) * (1.f / 512.f);
        float s2 = 0.f;
#pragma unroll
        for (int e = 0; e < 8; ++e) { hv[e] -= mu; s2 += hv[e] * hv[e]; }
        const float r = __builtin_amdgcn_rsqf(wave_sum(s2) * (1.f / 512.f) + EPS_);
        const f32x4 nw0 = *(const f32x4*)(nwp + hd * 512 + lane * 8), nw1 = *(const f32x4*)(nwp + hd * 512 + lane * 8 + 4);
        const f32x4 sk0 = *(const f32x4*)(skp + hd * 512 + lane * 8), sk1 = *(const f32x4*)(skp + hd * 512 + lane * 8 + 4);
        float y[8];
#pragma unroll
        for (int e = 0; e < 4; ++e) { y[e] = (hv[e] * r * nw0[e] + sk0[e] * xv[e]) * silu_(zv[e]); y[4 + e] = (hv[4 + e] * r * nw1[e] + sk1[e] * xv[4 + e]) * silu_(zv[4 + e]); }
        *(u32x4*)(H + base) = pack8f(y);
    }
}

DI void phase_scan(const Params& p, unsigned char* shm) {
    LAS unsigned char* lds = (LAS unsigned char*)shm;
    constexpr int TR = 400, TSZ = 64 * TR;
    const bf16_t* LA = (const bf16_t*)(p.ws + WS_LA); const bf16_t* BT = (const bf16_t*)(p.ws + WS_BT); const bf16_t* G = (const bf16_t*)(p.ws + WS_RC);
    bf16_t* Y = (bf16_t*)(p.ws + WS_RB);
    const int tid = opq(threadIdx.x);
    for (int unit = blockIdx.x; unit < 256; unit += gridDim.x) {
        const int b = unit >> 3, cg0 = (unit & 7) * 192;
        int goff[3], loff[3];
#pragma unroll
        for (int j = 0; j < 3; ++j) { const int q = tid + 512 * j, row = q / 24, cc = q % 24; goff[j] = row * 1536 + cc * 8; loff[j] = row * TR + cc * 16; }
        const size_t base = (size_t)b * S_ * 1536 + cg0;
        u32x4 ra[3], rb[3], rg[3];
#pragma unroll
        for (int j = 0; j < 3; ++j) { ra[j] = *(const u32x4*)(LA + base + goff[j]); rb[j] = *(const u32x4*)(BT + base + goff[j]); rg[j] = *(const u32x4*)(G + base + goff[j]); }
        float hst = 0.f;
        for (int tile = 0; tile < 32; ++tile) {
            __syncthreads();
#pragma unroll
            for (int j = 0; j < 3; ++j) { *(LAS u32x4*)(lds + loff[j]) = ra[j]; *(LAS u32x4*)(lds + TSZ + loff[j]) = rb[j]; *(LAS u32x4*)(lds + 2 * TSZ + loff[j]) = rg[j]; }
            if (tile < 31) {
                const size_t nb = base + (size_t)(tile + 1) * 64 * 1536;
#pragma unroll
                for (int j = 0; j < 3; ++j) { ra[j] = *(const u32x4*)(LA + nb + goff[j]); rb[j] = *(const u32x4*)(BT + nb + goff[j]); rg[j] = *(const u32x4*)(G + nb + goff[j]); }
            }
            __syncthreads();
            if (tid < 192) {
#pragma unroll 8
                for (int r = 0; r < 64; ++r) {
                    const float la = __uint_as_float((unsigned)*(const LAS bf16_t*)(lds + r * TR + tid * 2) << 16);
                    const float bt = __uint_as_float((unsigned)*(const LAS bf16_t*)(lds + TSZ + r * TR + tid * 2) << 16);
                    const float g = __uint_as_float((unsigned)*(const LAS bf16_t*)(lds + 2 * TSZ + r * TR + tid * 2) << 16);
                    hst = __expf(la) * hst + bt;
                    *(LAS bf16_t*)(lds + 2 * TSZ + r * TR + tid * 2) = (bf16_t)(pk2(hst * g, 0.f) & 0xffffu);
                }
            }
            __syncthreads();
            const size_t ob = base + (size_t)tile * 64 * 1536;
#pragma unroll
            for (int j = 0; j < 3; ++j) *(u32x4*)(Y + ob + goff[j]) = *(const LAS u32x4*)(lds + 2 * TSZ + loff[j]);
        }
        __syncthreads();
    }
}

DI void phase_rglru(const Params& p, unsigned char* shm) {
    LAS unsigned char* lds = (LAS unsigned char*)shm;
    constexpr int TR = 400, XR = 0, XC = 26880, GT = XC + 25600, LAo = GT + 25600, BTo = LAo + 25600, CW = BTo + 25600, GB = CW + 3840;
    static_assert(GB + 2304 <= LDS_BYTES, "lds");
    const int tid = opq(threadIdx.x), lane = tid & 63, w = __builtin_amdgcn_readfirstlane(tid >> 6), fr = lane & 15, fq = lane >> 4;
    const bf16_t* XRg = (const bf16_t*)(p.ws + WS_RA); const bf16_t* Gg = (const bf16_t*)(p.ws + WS_RC); bf16_t* Y = (bf16_t*)(p.ws + WS_RB);
    const bf16_t* WG2 = (const bf16_t*)(p.ws + WS_WT_G); const float* SPp = (const float*)(p.ws + WS_SP);
    LAS float* cw = (LAS float*)(lds + CW); LAS float* gb = (LAS float*)(lds + GB);
    for (int unit = blockIdx.x; unit < 256; unit += gridDim.x) {
        const int b = unit >> 3, blk = unit & 7, cg0 = blk * 192;
        __syncthreads();
        for (int i = tid; i < 960; i += 512) { const int j = i / 192, c = i % 192; cw[i] = j < 4 ? p.in[15][j * 1536 + cg0 + c] : p.in[16][cg0 + c]; }
        for (int i = tid; i < 576; i += 512) { const int k = i / 192, c = i % 192; gb[i] = (k == 0 ? p.in[18] : (k == 1 ? p.in[20] : SPp))[cg0 + c]; }
        if (tid < 72) *(LAS u32x4*)(lds + XR + (tid / 24) * TR + (tid % 24) * 16) = (u32x4){0u, 0u, 0u, 0u};
        bf16x8 Bf[4][6];
        const int chb = w < 4 ? 32 * w : 128 + 16 * (w - 4);
        {
#pragma unroll
          for (int nt = 0; nt < 4; ++nt)
#pragma unroll
              for (int kk = 0; kk < 6; ++kk) {
                  const int chn = chb + ((w < 4) ? 16 * (nt & 1) : 0) + fr;
                  Bf[nt][kk] = *(const bf16x8*)(WG2 + ((size_t)((blk * 2 + (nt >> 1)) * 192 + chn) * 192 + 32 * kk + 8 * fq)); } }
        int goff[3], loff[3];
#pragma unroll
        for (int j = 0; j < 3; ++j) { const int q = tid + 512 * j, row = q / 24, cc = q % 24; goff[j] = row * 1536 + cc * 8; loff[j] = row * TR + cc * 16; }
        const size_t base = (size_t)b * S_ * 1536 + cg0;
        u32x4 rx[3], rg[3];
#pragma unroll
        for (int j = 0; j < 3; ++j) { rx[j] = *(const u32x4*)(XRg + base + goff[j]); rg[j] = *(const u32x4*)(Gg + base + goff[j]); }
        float hst = 0.f;
        for (int tile = 0; tile < 32; ++tile) {
            __syncthreads();
#pragma unroll
            for (int j = 0; j < 3; ++j) { *(LAS u32x4*)(lds + XR + 3 * TR + loff[j]) = rx[j]; *(LAS u32x4*)(lds + GT + loff[j]) = rg[j]; }
            if (tile < 31) {
                const size_t nb = base + (size_t)(tile + 1) * 64 * 1536;
#pragma unroll
                for (int j = 0; j < 3; ++j) { rx[j] = *(const u32x4*)(XRg + nb + goff[j]); rg[j] = *(const u32x4*)(Gg + nb + goff[j]); }
            }
            __syncthreads();
#pragma unroll
            for (int j = 0; j < 3; ++j) {
                const int q = tid + 512 * j, cc = q % 24;
                float a8[8];
                { const f32x4 b0 = *(const LAS f32x4*)(cw + 768 + 8 * cc), b1 = *(const LAS f32x4*)(cw + 768 + 8 * cc + 4);
#pragma unroll
                  for (int e = 0; e < 4; ++e) { a8[e] = b0[e]; a8[4 + e] = b1[e]; } }
#pragma unroll
                for (int jj = 0; jj < 4; ++jj) {
                    float xin[8]; { const u32x4 xraw = *(const LAS u32x4*)(lds + XR + jj * TR + loff[j]); unpack8(xraw, xin); }
                    const f32x4 w0 = *(const LAS f32x4*)(cw + jj * 192 + 8 * cc), w1 = *(const LAS f32x4*)(cw + jj * 192 + 8 * cc + 4);
#pragma unroll
                    for (int e = 0; e < 4; ++e) { a8[e] += w0[e] * xin[e]; a8[4 + e] += w1[e] * xin[4 + e]; }
                }
                *(LAS u32x4*)(lds + XC + loff[j]) = pack8f(a8);
            }
            __syncthreads();
            {
#pragma unroll
                for (int u = 0; u < 2; ++u) {
                    if (u == 1 && w >= 4) break;
                    f32x4 acc[4][2];
#pragma unroll
                    for (int mt = 0; mt < 4; ++mt) { acc[mt][0] = (f32x4){0.f, 0.f, 0.f, 0.f}; acc[mt][1] = (f32x4){0.f, 0.f, 0.f, 0.f}; }
#pragma unroll
                    for (int kk = 0; kk < 6; ++kk)
#pragma unroll
                        for (int mt = 0; mt < 4; ++mt) {
                            const bf16x8 af = *(const LAS bf16x8*)(lds + XC + (16 * mt + fr) * TR + (32 * kk + 8 * fq) * 2);
                            acc[mt][0] = __builtin_amdgcn_mfma_f32_16x16x32_bf16(af, Bf[u][kk], acc[mt][0], 0, 0, 0);
                            acc[mt][1] = __builtin_amdgcn_mfma_f32_16x16x32_bf16(af, Bf[2 + u][kk], acc[mt][1], 0, 0, 0);
                        }
                    const int ch = chb + 16 * u + fr;
                    const float ba = gb[ch], bx = gb[192 + ch], sp = gb[384 + ch];
#pragma unroll
                    for (int mt = 0; mt < 4; ++mt)
#pragma unroll
                        for (int j = 0; j < 4; ++j) {
                            const int t = 16 * mt + 4 * fq + j;
                            const float ea = 1.f + __expf(fminf(-(acc[mt][0][j] + ba), 40.f)), ex = 1.f + __expf(fminf(-(acc[mt][1][j] + bx), 40.f));
                            const float inv = __builtin_amdgcn_rcpf(ea * ex);
                            const float r = inv * ex, ig = inv * ea;
                            const float av = __expf(r * sp), om = 1.f - av;
                            const float xcv = __uint_as_float((unsigned)*(const LAS bf16_t*)(lds + XC + t * TR + ch * 2) << 16);
                            const float bt = __builtin_amdgcn_sqrtf(fmaxf(om * (1.f + av), 0.f)) * (ig * xcv);
                            *(LAS bf16_t*)(lds + LAo + t * TR + ch * 2) = (bf16_t)(pk2(om, 0.f) & 0xffffu);
                            *(LAS bf16_t*)(lds + BTo + t * TR + ch * 2) = (bf16_t)(pk2(bt, 0.f) & 0xffffu);
                        }
                    __builtin_amdgcn_sched_barrier(0);
                }
            }
            __syncthreads();
            if (tid < 192) {
#pragma unroll 8
                for (int r = 0; r < 64; ++r) {
                    const float om = __uint_as_float((unsigned)*(const LAS bf16_t*)(lds + LAo + r * TR + tid * 2) << 16);
                    const float bt = __uint_as_float((unsigned)*(const LAS bf16_t*)(lds + BTo + r * TR + tid * 2) << 16);
                    const float g = __uint_as_float((unsigned)*(const LAS bf16_t*)(lds + GT + r * TR + tid * 2) << 16);
                    hst = (hst - om * hst) + bt;
                    *(LAS bf16_t*)(lds + GT + r * TR + tid * 2) = (bf16_t)(pk2(hst * g, 0.f) & 0xffffu);
                }
            } else if (tid >= 256 && tid < 328) {
                const int i = tid - 256, r = i / 24, cc = i % 24;
                const u32x4 v = *(const LAS u32x4*)(lds + XR + (64 + r) * TR + cc * 16);
                *(LAS u32x4*)(lds + XR + r * TR + cc * 16) = v;
            }
            __syncthreads();
            const size_t ob = base + (size_t)tile * 64 * 1536;
#pragma unroll
            for (int j = 0; j < 3; ++j) *(u32x4*)(Y + ob + goff[j]) = *(const LAS u32x4*)(lds + GT + loff[j]);
        }
        __syncthreads();
    }
}


#define XB_TMO      128
#define XB_XCNT(j)  (256  + 64 * (j))
#define XB_XSUB(j)  (1280 + 64 * (j))
#define XB_XGEN(j)  (2304 + 64 * (j))
#define XB_TOP      3328
#define XB_TOPGEN   3392
#define XCD_BAR_WORDS 3456
#define XB_SPIN_CAP (1u << 18)
DI unsigned xb_ld(unsigned* p)              { return __hip_atomic_load(p, __ATOMIC_RELAXED, __HIP_MEMORY_SCOPE_AGENT); }
DI unsigned xb_add(unsigned* p, unsigned v) { return __hip_atomic_fetch_add(p, v, __ATOMIC_RELAXED, __HIP_MEMORY_SCOPE_AGENT); }
DI unsigned xb_xcc_id() { return (unsigned)__builtin_amdgcn_s_getreg((3 << 11) | 20) & 0xFu; }
#define XB_SPIN(cond, bar) do { unsigned _sp = 0; while (cond) { __builtin_amdgcn_s_sleep(1); \
    if ((++_sp & 255u) == 0u) { if (xb_ld(&(bar)[XB_TMO])) break; if (_sp > XB_SPIN_CAP) { atomicAdd(&(bar)[XB_TMO], 1u); break; } } } } while (0)
struct XcdBarrier { unsigned* bar; unsigned x; volatile LAS unsigned* st; };
DI XcdBarrier xcd_barrier_post(unsigned* bar, volatile LAS unsigned* st) {
    XcdBarrier b; b.bar = bar; b.x = xb_xcc_id(); b.st = st;
    if (threadIdx.x == 0) (void)xb_add(&bar[XB_XCNT(b.x)], 1u);
    return b;
}
DI void xcd_barrier_complete(unsigned* bar, unsigned x, unsigned& nloc, unsigned& nx) {
    const unsigned G = gridDim.x * gridDim.y * gridDim.z;
    unsigned sum, cnt, mine, sp = 0u;
    for (;;) {
        sum = 0u; cnt = 0u; mine = 0u;
#pragma unroll
        for (unsigned j = 0; j < 16; ++j) { const unsigned c = xb_ld(&bar[XB_XCNT(j)]); sum += c; cnt += (c > 0u) ? 1u : 0u; mine = (j == x) ? c : mine; }
        if (sum == G) break;
        __builtin_amdgcn_s_sleep(1);
        if ((++sp & 255u) == 0u) { if (xb_ld(&bar[XB_TMO])) break; if (sp > XB_SPIN_CAP) { atomicAdd(&bar[XB_TMO], 1u); break; } }
    }
    nloc = mine > 0u ? mine : 1u; nx = cnt > 0u ? cnt : 1u;
}
DI void xcd_barrier(const XcdBarrier& b) {
    asm volatile("s_waitcnt vmcnt(0)" ::: "memory");
    __syncthreads();
    if (threadIdx.x == 0) {
        unsigned* bar = b.bar;
        __builtin_amdgcn_s_waitcnt(0);
        unsigned nloc = b.st[0], nx = b.st[1];
        if (nloc == 0u) { xcd_barrier_complete(bar, b.x, nloc, nx); b.st[0] = nloc; b.st[1] = nx; }
        const unsigned old = xb_add(&bar[XB_XSUB(b.x)], 1u);
        const unsigned gen = old / nloc;
        if (old + 1u == (gen + 1u) * nloc) {
            __builtin_amdgcn_fence(__ATOMIC_RELEASE, "agent");
            asm volatile("s_waitcnt vmcnt(0)" ::: "memory");
            const unsigned og = xb_add(&bar[XB_TOP], 1u);
            const unsigned tg = og / nx;
            if (og + 1u == (tg + 1u) * nx) xb_add(&bar[XB_TOPGEN], 1u);
            else XB_SPIN(xb_ld(&bar[XB_TOPGEN]) == tg, bar);
            __builtin_amdgcn_fence(__ATOMIC_ACQUIRE, "agent");
            xb_add(&bar[XB_XGEN(b.x)], 1u);
            asm volatile("s_waitcnt vmcnt(0)" ::: "memory");
        } else {
            XB_SPIN(xb_ld(&bar[XB_XGEN(b.x)]) == gen, bar);
            __builtin_amdgcn_fence(__ATOMIC_ACQUIRE, "agent");
            asm volatile("s_waitcnt vmcnt(0)" ::: "memory");
        }
    }
    __syncthreads();
}

__global__ void __launch_bounds__(512) hybrid_fwd(Params p) {
    extern __shared__ __attribute__((aligned(16))) unsigned char shm[];
    LAS unsigned char* lds = (LAS unsigned char*)shm;
    cg::grid_group grid = cg::this_grid();
    volatile LAS unsigned* xst = (volatile LAS unsigned*)(lds + 140272);
    if (threadIdx.x == 0) { xst[0] = 0u; xst[1] = 0u; }
    __syncthreads();
    if (blockIdx.x == 0) { unsigned* bw = (unsigned*)(p.ws + WS_BAR); for (int i = threadIdx.x; i < XCD_BAR_WORDS; i += 512) bw[i] = 0u; }
    grid.sync();
    XcdBarrier xb = xcd_barrier_post((unsigned*)(p.ws + WS_BAR), xst);
    unsigned char* ws = p.ws;
    bf16_t* U = (bf16_t*)(ws + WS_U); bf16_t* RA = (bf16_t*)(ws + WS_RA); bf16_t* RB = (bf16_t*)(ws + WS_RB); bf16_t* RC = (bf16_t*)(ws + WS_RC);
    bf16_t* OUTB = (bf16_t*)p.out;

    PH_BEGIN(0)
    phase_prep(p, shm);
    PH_END
    PH_BEGIN(1)
    { const char* A = (const char*)U; const char* B = (const char*)(ws + WS_WT_XM);
      gemm_phase<true>(lds, 256, 8, 1024, 1024, 1024,
          [=](int pm, int pn, const char*& a, const char*& b) { a = A + (size_t)pm * 256 * 1024 * 2; b = B + (size_t)pn * 256 * 1024 * 2; },
          [=](const f32x4 (&acc)[2][2][4][2], int pm, int pn, int wr, int wc, int fr, int fq) { epi_bf16<0>(acc, RA + (size_t)pm * 256 * 2048 + pn * 256, 2048, wr, wc, fr, fq); }); }
    PH_END
    PH_BEGIN(2)
    if (blockIdx.x < 16) gate_scan(p);
    conv0_phase(RA, p.in[4], p.in[5], RB);
    PH_END
    PH_BEGIN(3)
    { const char* XC = (const char*)RB; const char* XM = (const char*)RA; const char* WQK = (const char*)(ws + WS_WT_QK); const char* WV = (const char*)(ws + WS_WT_V);
      gemm_phase<true>(lds, 256, 16, 512, 2048, 512,
          [=](int pm, int pn, const char*& a, const char*& b) {
              if (pn < 8) { a = XC + ((size_t)pm * 256 * 2048 + (pn >> 1) * 512) * 2; b = WQK + (size_t)pn * 256 * 512 * 2; }
              else { a = XM + ((size_t)pm * 256 * 2048 + ((pn - 8) >> 1) * 512) * 2; b = WV + (size_t)(pn - 8) * 256 * 512 * 2; } },
          [=](const f32x4 (&acc)[2][2][4][2], int pm, int pn, int wr, int wc, int fr, int fq) {
              if (pn < 8) epi_bf16<0>(acc, OUTB + (size_t)(pn & 1) * T_ * 1024 + (size_t)pm * 256 * 1024 + (pn >> 1) * 256, 1024, wr, wc, fr, fq);
              else epi_bf16<0>(acc, RC + (size_t)pm * 256 * 2048 + (pn - 8) * 256, 2048, wr, wc, fr, fq); }); }
    PH_END
    PH_BEGIN(4)
    phase_mlstm(p, shm);
    PH_END
    PH_BEGIN(5)
    { const char* A = (const char*)U; const char* B = (const char*)(ws + WS_WT_ZO);
      gemm_phase<true>(lds, 256, 16, 1024, 1024, 1024,
          [=](int pm, int pn, const char*& a, const char*& b) { a = A + (size_t)pm * 256 * 1024 * 2; b = B + (size_t)pn * 256 * 1024 * 2; },
          [=](const f32x4 (&acc)[2][2][4][2], int pm, int pn, int wr, int wc, int fr, int fq) {
              if (pn < 8) epi_bf16<0>(acc, RC + (size_t)pm * 256 * 2048 + pn * 256, 2048, wr, wc, fr, fq);
              else epi_bf16<0>(acc, OUTB + (size_t)pm * 256 * 2048 + (pn - 8) * 256, 2048, wr, wc, fr, fq); }); }
    PH_END
    PH_BEGIN(6)
    phase_post(p);
    PH_END
    PH_BEGIN(7)
    { const char* A = (const char*)RA; const char* B = (const char*)(ws + WS_WT_OUT0); const float* X = p.in[0]; float* X1 = p.out; float* SS1 = (float*)(ws + WS_SS1);
      gemm_phase<false>(lds, 256, 4, 2048, 2048, 2048,
          [=](int pm, int pn, const char*& a, const char*& b) { a = A + (size_t)pm * 256 * 2048 * 2; b = B + (size_t)pn * 256 * 2048 * 2; },
          [=](const f32x4 (&acc)[2][2][4][2], int pm, int pn, int wr, int wc, int fr, int fq) {
#pragma unroll
              for (int ai = 0; ai < 2; ++ai)
#pragma unroll
                  for (int m = 0; m < 4; ++m) { const int row = pm * 256 + ai * 128 + wr * 64 + m * 16 + fr; const size_t ro = (size_t)row * 1024 + pn * 256 + wc * 32 + 4 * fq;
                      float ssq = 0.f;
#pragma unroll
                      for (int bj = 0; bj < 2; ++bj)
#pragma unroll
                          for (int n = 0; n < 2; ++n) { const size_t o = ro + bj * 128 + n * 16; const f32x4 v = *(const f32x4*)(X + o) + acc[ai][bj][m][n];
                              u32x2 wv; wv[0] = pk2(v[0], v[1]); wv[1] = pk2(v[2], v[3]); *(u32x2*)(U + o) = wv;
                              ssq += v[0] * v[0] + v[1] * v[1] + v[2] * v[2] + v[3] * v[3]; }
                      ssq += __shfl_xor(ssq, 16); ssq += __shfl_xor(ssq, 32);
                      if (fq == 0) unsafeAtomicAdd(SS1 + row, ssq); } }); }
    PH_END
    PH_BEGIN(9)
    { const char* A = (const char*)U; const char* B = (const char*)(ws + WS_WT_IN1);
      gemm_phase<true>(lds, 256, 12, 1024, 1024, 1024,
          [=](int pm, int pn, const char*& a, const char*& b) { a = A + (size_t)pm * 256 * 1024 * 2; b = B + (size_t)pn * 256 * 1024 * 2; },
          [=](const f32x4 (&acc)[2][2][4][2], int pm, int pn, int wr, int wc, int fr, int fq) {
              const float* ssr = (const float*)(ws + WS_SS1) + pm * 256;
              if (pn < 6) epi_bf16<0>(acc, RA + (size_t)pm * 256 * 1536 + pn * 256, 1536, wr, wc, fr, fq, ssr);
              else epi_bf16<1>(acc, RC + (size_t)pm * 256 * 1536 + (pn - 6) * 256, 1536, wr, wc, fr, fq, ssr); }); }
    PH_END
    PH_BEGIN(10)
    phase_rglru(p, shm);
    PH_END
    { const char* A = (const char*)RB; const char* B = (const char*)(ws + WS_WT_OUT1); bf16_t* X2B = RA; const f32x4* fg = (const f32x4*)p.in[2]; f32x4* O4 = (f32x4*)p.out;
      LAS float* rowss = (LAS float*)(lds + 131072);
      for (int panel = blockIdx.x; panel < 256; panel += gridDim.x) {
          { const int tid = opq(threadIdx.x); if (tid < 256) rowss[tid] = 0.f; }
          __syncthreads();
          gemm_phase<false>(lds, 256, 4, 1536, 1536, 1536,
              [=](int pm, int pn, const char*& a, const char*& b) { a = A + (size_t)pm * 256 * 1536 * 2; b = B + (size_t)pn * 256 * 1536 * 2; },
              [=](const f32x4 (&acc)[2][2][4][2], int pm, int pn, int wr, int wc, int fr, int fq) {
#pragma unroll
                  for (int ai = 0; ai < 2; ++ai)
#pragma unroll
                      for (int m = 0; m < 4; ++m) { const int rl = ai * 128 + wr * 64 + m * 16 + fr; const size_t ro = (size_t)(pm * 256 + rl) * 1024 + pn * 256 + wc * 32 + 4 * fq;
                          float ssq = 0.f;
#pragma unroll
                          for (int bj = 0; bj < 2; ++bj)
#pragma unroll
                              for (int n = 0; n < 2; ++n) { const size_t o = ro + bj * 128 + n * 16; const u32x2 xb = *(const u32x2*)(U + o);
                                  const f32x4 v = (f32x4){bflo(xb[0]), bfhi(xb[0]), bflo(xb[1]), bfhi(xb[1])} + acc[ai][bj][m][n];
                                  u32x2 wv; wv[0] = pk2(v[0], v[1]); wv[1] = pk2(v[2], v[3]); *(u32x2*)(X2B + o) = wv;
                                  ssq += v[0] * v[0] + v[1] * v[1] + v[2] * v[2] + v[3] * v[3]; }
                          ssq += __shfl_xor(ssq, 16); ssq += __shfl_xor(ssq, 32);
                          if (fq == 0) __hip_atomic_fetch_add((float*)(shm + 131072) + rl, ssq, __ATOMIC_RELAXED, __HIP_MEMORY_SCOPE_WORKGROUP); } }, panel);
          asm volatile("s_waitcnt vmcnt(0)" ::: "memory");
          __syncthreads();
          { const int tid = opq(threadIdx.x);
            for (int idx = tid; idx < 256 * 128; idx += 512) {
                const int row = idx >> 7, c = idx & 127; const size_t go = (size_t)(panel * 256 + row);
                const u32x4 xb = *(const u32x4*)(X2B + go * 1024 + c * 8);
                const float r = __builtin_amdgcn_rsqf(rowss[row] * (1.f / 1024.f) + EPS_);
                float f[8]; unpack8(xb, f);
                const f32x4 g0 = fg[2 * c], g1 = fg[2 * c + 1];
                O4[go * 256 + 2 * c] = (f32x4){f[0], f[1], f[2], f[3]} * r * g0;
                O4[go * 256 + 2 * c + 1] = (f32x4){f[4], f[5], f[6], f[7]} * r * g1; } }
          __syncthreads();
      } }
}

extern "C" void kernel_launch(void* const* d_in, const int* in_sizes, int n_in, void* d_out, int out_size, void* d_ws, size_t ws_size, hipStream_t stream) {
    static int grid_blocks = 0;
    if (!grid_blocks) {
        int dev = 0, cus = 0, per_cu = 0;
        hipGetDevice(&dev);
        hipDeviceGetAttribute(&cus, hipDeviceAttributeMultiprocessorCount, dev);
        hipFuncSetAttribute((const void*)hybrid_fwd, hipFuncAttributeMaxDynamicSharedMemorySize, LDS_BYTES);
        hipOccupancyMaxActiveBlocksPerMultiprocessor(&per_cu, (const void*)hybrid_fwd, 512, LDS_BYTES);
        if (per_cu < 1) { fprintf(stderr, "occupancy query returned %d\n", per_cu); per_cu = 1; }
        grid_blocks = cus * per_cu;
        if (grid_blocks > 256) grid_blocks = 256;
    }
    Params p{};
    for (int i = 0; i < 23; ++i) p.in[i] = (const float*)d_in[i];
    p.out = (float*)d_out; p.ws = (unsigned char*)d_ws; p.rep_mask = REP_MASK;
    void* args[] = {&p};
    hipError_t e = hipLaunchCooperativeKernel((const void*)hybrid_fwd, dim3(grid_blocks), dim3(512), args, LDS_BYTES, stream);
    if (e != hipSuccess) fprintf(stderr, "cooperative launch failed: %s (grid %d)\n", hipGetErrorString(e), grid_blocks);
}
```

```cpp
#include <hip/hip_runtime.h>
#include <hip/hip_cooperative_groups.h>
#include <cstdio>
namespace cg = cooperative_groups;

#define DI __device__ __forceinline__
#define LAS __attribute__((address_space(3)))
typedef unsigned short bf16_t;
typedef short bf16x8 __attribute__((ext_vector_type(8)));
typedef short s16x4 __attribute__((ext_vector_type(4)));
typedef float f32x2 __attribute__((ext_vector_type(2)));
typedef float f32x4 __attribute__((ext_vector_type(4)));
typedef float f32x16 __attribute__((ext_vector_type(16)));
typedef unsigned u32x2 __attribute__((ext_vector_type(2)));
typedef unsigned u32x4 __attribute__((ext_vector_type(4)));
typedef __bf16 bf2_t __attribute__((ext_vector_type(2)));

constexpr int T_ = 65536, S_ = 2048;
constexpr float EPS_ = 1e-6f;
constexpr size_t MB_ = 1u << 20;
constexpr size_t WS_WT_XM = 0, WS_WT_ZO = 4 * MB_, WS_WT_QK = 12 * MB_, WS_WT_V = 14 * MB_, WS_WT_OUT0 = 16 * MB_, WS_WT_IN1 = 20 * MB_,
                 WS_WT_G = 26 * MB_, WS_WT_OUT1 = 28 * MB_, WS_LI = 31 * MB_, WS_LF = 32 * MB_, WS_GP = 33 * MB_, WS_GQ = 34 * MB_, WS_GD = 35 * MB_,
                 WS_GF = 36 * MB_, WS_GW = 37 * MB_, WS_SS = 38 * MB_, WS_U = 40 * MB_, WS_RA = 168 * MB_, WS_RB = 424 * MB_, WS_RC = 680 * MB_,
                 WS_LA = 40 * MB_, WS_BT = 232 * MB_, WS_SP = 39 * MB_, WS_SS1 = 38 * MB_ + 512 * 1024, WS_BAR = 39 * MB_ + 65536;
constexpr int LDS_BYTES = 140288;

struct Params { const float* in[23]; float* out; unsigned char* ws; unsigned rep_mask; unsigned pad; };
#ifndef REP_MASK
#define REP_MASK 0u
#endif
#ifndef PH_MASK
#define PH_MASK 0xffffu
#endif
#define PH_BEGIN(k) for (int r_ = 0, n_ = ((PH_MASK >> (k)) & 1u) ? 1 + (int)((p.rep_mask >> (k)) & 1u) : 0; r_ < n_; ++r_) {
#define PH_END xcd_barrier(xb); }
#define PH_END_CG grid.sync(); }

DI unsigned pk2(float a, float b) { f32x2 v = {a, b}; bf2_t r = __builtin_convertvector(v, bf2_t); return __builtin_bit_cast(unsigned, r); }
DI int opq(int x) { asm volatile("" : "+v"(x)); return x; }
DI float bflo(unsigned u) { return __uint_as_float(u << 16); }
DI float bfhi(unsigned u) { return __uint_as_float(u & 0xffff0000u); }
DI float sigm(float x) { return __builtin_amdgcn_rcpf(1.f + __expf(-x)); }
DI float silu_(float x) { return x * __builtin_amdgcn_rcpf(1.f + __expf(-x)); }
DI float wave_sum(float v) {
    v += __int_as_float(__builtin_amdgcn_update_dpp(0, __float_as_int(v), 0xB1, 0xf, 0xf, true));
    v += __int_as_float(__builtin_amdgcn_update_dpp(0, __float_as_int(v), 0x4E, 0xf, 0xf, true));
    v += __int_as_float(__builtin_amdgcn_update_dpp(0, __float_as_int(v), 0x141, 0xf, 0xf, true));
    v += __int_as_float(__builtin_amdgcn_update_dpp(0, __float_as_int(v), 0x140, 0xf, 0xf, true));
    const int vi = __float_as_int(v);
    return (__int_as_float(__builtin_amdgcn_readlane(vi, 0)) + __int_as_float(__builtin_amdgcn_readlane(vi, 16))) +
           (__int_as_float(__builtin_amdgcn_readlane(vi, 32)) + __int_as_float(__builtin_amdgcn_readlane(vi, 48)));
}
DI void unpack8(const u32x4& u, float (&f)[8]) {
#pragma unroll
    for (int i = 0; i < 4; ++i) { f[2 * i] = bflo(u[i]); f[2 * i + 1] = bfhi(u[i]); }
}
DI unsigned pk_fp8x4(float a, float b, float c, float d) { int w = __builtin_amdgcn_cvt_pk_fp8_f32(a, b, 0, false); w = __builtin_amdgcn_cvt_pk_fp8_f32(c, d, w, true); return (unsigned)w; }
DI void unpack_fp8x8(const u32x2& u, float (&f)[8]) {
    f[0] = __builtin_amdgcn_cvt_f32_fp8((int)u[0], 0); f[1] = __builtin_amdgcn_cvt_f32_fp8((int)u[0], 1); f[2] = __builtin_amdgcn_cvt_f32_fp8((int)u[0], 2); f[3] = __builtin_amdgcn_cvt_f32_fp8((int)u[0], 3);
    f[4] = __builtin_amdgcn_cvt_f32_fp8((int)u[1], 0); f[5] = __builtin_amdgcn_cvt_f32_fp8((int)u[1], 1); f[6] = __builtin_amdgcn_cvt_f32_fp8((int)u[1], 2); f[7] = __builtin_amdgcn_cvt_f32_fp8((int)u[1], 3);
}
DI u32x4 pack8f(const float (&f)[8]) { u32x4 r; r[0] = pk2(f[0], f[1]); r[1] = pk2(f[2], f[3]); r[2] = pk2(f[4], f[5]); r[3] = pk2(f[6], f[7]); return r; }

constexpr int BM = 256, BK = 64, HALF = 128, HTB = HALF * BK * 2, NXCD = 8, WGM = 8;
DI int lds_byte(int r, int c) { const int st = (r >> 4) * 2 + (c >> 5), rr = r & 15, cc = c & 31, ob = rr * 64 + cc * 2; return st * 1024 + (ob ^ (((ob >> 9) & 1) << 5)); }
DI void stage_rc(int b, int& R, int& C) { const int st = b / 1024, sb = b % 1024, swz = sb ^ (((sb >> 9) & 1) << 5); R = (st >> 1) * 16 + swz / 64; C = (st & 1) * 32 + (swz % 64) / 2; }
DI int perm32(int rho) { const int n = rho >> 4, i = rho & 15; return 8 * (i >> 2) + 4 * n + (i & 3); }

DI bool unit_next(int i, int nM, int nN, int& pm, int& pn) {
    const int nwg = nM * nN; const long L = (long)i * gridDim.x + blockIdx.x; if (L >= nwg) return false;
    int wgid = (int)L; { const int q = nwg / NXCD, r = nwg % NXCD, xcd = wgid % NXCD, off = wgid / NXCD; wgid = (xcd < r ? xcd * (q + 1) : r * (q + 1) + (xcd - r) * q) + off; }
    const int nig = WGM * nN, gid = wgid / nig, fm = gid * WGM, gsz = (nM - fm) < WGM ? (nM - fm) : WGM;
    pm = fm + ((wgid % nig) % gsz); pn = (wgid % nig) / gsz; return true;
}

template <bool PERM, class Dec, class Epi>
DI void gemm_phase(LAS unsigned char* lds, const int nM, const int nN, const int K, const int lda, const int ldb, const Dec& dec, const Epi& epi, const int panel = -1) {
    const int tid = opq(threadIdx.x), wid = __builtin_amdgcn_readfirstlane(tid >> 6), lane = tid & 63, wr = wid >> 2, wc = wid & 3, fr = lane & 15, fq = lane >> 4;
    const int nt = K / BK;
    unsigned voffA[2], voffB[2];
#pragma unroll
    for (int i = 0; i < 2; ++i) { int R, C; stage_rc(tid * 16 + i * 8192, R, C); const int Rb = PERM ? ((R & ~31) + perm32(R & 31)) : R;
        voffA[i] = (unsigned)(R * lda + C) * 2u; voffB[i] = (unsigned)(Rb * ldb + C) * 2u; }
    const size_t kstep = (size_t)(BK * 2);
    const size_t hstepA = (size_t)HALF * lda * 2, hstepB = (size_t)HALF * ldb * 2;
    const unsigned ldsw = (unsigned)wid * 1024u;
    const int aoff = lds_byte(wr * 64 + fr, fq * 8), boff = lds_byte(wc * 32 + fr, fq * 8);
#define G_SA(b, h) (((b) * 2 + (h)) * HTB)
#define G_SB(b, h) ((4 + (b) * 2 + (h)) * HTB)
#define G_STAGE(bufoff, gbase, voff) do { _Pragma("unroll") for (int _i = 0; _i < 2; ++_i) \
        __builtin_amdgcn_global_load_lds((const unsigned*)((const char*)(gbase) + (voff)[_i]), (LAS unsigned*)(lds + (bufoff) + ldsw + _i * 8192), 16, 0, 0); } while (0)
#define G_LDA(dst, b, h) do { _Pragma("unroll") for (int m = 0; m < 4; ++m) _Pragma("unroll") for (int k = 0; k < 2; ++k) dst[m][k] = *(const LAS bf16x8*)(lds + G_SA(b, h) + aoff + m * 2048 + k * 1024); } while (0)
#define G_LDB(dst, b, h) do { _Pragma("unroll") for (int n = 0; n < 2; ++n) _Pragma("unroll") for (int k = 0; k < 2; ++k) dst[n][k] = *(const LAS bf16x8*)(lds + G_SB(b, h) + boff + n * 2048 + k * 1024); } while (0)
#define G_MMA(ai, bj, At, Bt) do { __builtin_amdgcn_s_setprio(1); _Pragma("unroll") for (int m = 0; m < 4; ++m) _Pragma("unroll") for (int n = 0; n < 2; ++n) _Pragma("unroll") for (int k = 0; k < 2; ++k) \
        acc[ai][bj][m][n] = __builtin_amdgcn_mfma_f32_16x16x32_bf16(Bt[n][k], At[m][k], acc[ai][bj][m][n], 0, 0, 0); __builtin_amdgcn_s_setprio(0); } while (0)
#define G_WAIT_V(n) asm volatile("s_waitcnt vmcnt(" #n ")" ::: "memory")
#define G_WAIT_L(n) asm volatile("s_waitcnt lgkmcnt(" #n ")" ::: "memory")
#define G_BAR __builtin_amdgcn_s_barrier()
#define G_SCHED __builtin_amdgcn_sched_barrier(0)
    int cpm, cpn, npm, npn, ui = 0;
    if (panel >= 0) { cpm = panel; cpn = 0; } else if (!unit_next(0, nM, nN, cpm, cpn)) return;
    f32x4 acc[2][2][4][2];
#pragma unroll
    for (int a = 0; a < 2; ++a)
#pragma unroll
        for (int b = 0; b < 2; ++b)
#pragma unroll
            for (int m = 0; m < 4; ++m)
#pragma unroll
                for (int n = 0; n < 2; ++n) acc[a][b][m][n] = (f32x4){0.f, 0.f, 0.f, 0.f};
    bf16x8 At[4][2], B0[2][2], B1[2][2];
    const char* cA; const char* cB; dec(cpm, cpn, cA, cB);
    G_STAGE(G_SB(0, 0), cB, voffB); G_STAGE(G_SA(0, 0), cA, voffA); G_STAGE(G_SB(0, 1), cB + hstepB, voffB); G_STAGE(G_SA(0, 1), cA + hstepA, voffA);
    if (wr == 1) G_BAR;
    G_WAIT_V(4); G_BAR;
    G_STAGE(G_SB(1, 0), cB + kstep, voffB); G_STAGE(G_SA(1, 0), cA + kstep, voffA); G_STAGE(G_SB(1, 1), cB + hstepB + kstep, voffB);
    G_WAIT_V(6); G_BAR;
    for (;;) {
        bool has_next;
        if (panel >= 0) { has_next = (ui + 1 < nN); npm = panel; npn = ui + 1; } else has_next = unit_next(ui + 1, nM, nN, npm, npn);
        const char* nA = cA; const char* nB = cB; if (has_next) dec(npm, npn, nA, nB);
#pragma nounroll
        for (int t = 0; t < nt; t += 2) {
            const bool last = (t == nt - 2);
            const char* a1 = cA + (size_t)(t + 1) * kstep;
            const char* a2 = last ? nA : cA + (size_t)(t + 2) * kstep; const char* b2 = last ? nB : cB + (size_t)(t + 2) * kstep;
            const char* a3 = a2 + kstep; const char* b3 = b2 + kstep;
            G_LDB(B0, 0, 0); G_SCHED; G_LDA(At, 0, 0); G_STAGE(G_SA(1, 1), a1 + hstepA, voffA);
            G_WAIT_L(8); G_BAR; G_WAIT_L(0); G_MMA(0, 0, At, B0); G_BAR; G_SCHED;
            G_LDB(B1, 0, 1); G_STAGE(G_SB(0, 0), b2, voffB);
            G_BAR; G_WAIT_L(0); G_MMA(0, 1, At, B1); G_BAR;
            G_LDA(At, 0, 1); G_STAGE(G_SA(0, 0), a2, voffA);
            G_BAR; G_WAIT_L(0); G_MMA(1, 0, At, B0); G_BAR; G_SCHED;
            G_STAGE(G_SB(0, 1), b2 + hstepB, voffB);
            G_WAIT_V(6); G_BAR; G_MMA(1, 1, At, B1); G_BAR;
            G_LDB(B0, 1, 0); G_SCHED; G_LDA(At, 1, 0); G_STAGE(G_SA(0, 1), a2 + hstepA, voffA);
            G_WAIT_L(8); G_BAR; G_WAIT_L(0); G_MMA(0, 0, At, B0); G_BAR; G_SCHED;
            G_LDB(B1, 1, 1); G_STAGE(G_SB(1, 0), b3, voffB);
            G_BAR; G_WAIT_L(0); G_MMA(0, 1, At, B1); G_BAR;
            G_LDA(At, 1, 1); G_STAGE(G_SA(1, 0), a3, voffA);
            G_BAR; G_WAIT_L(0); G_MMA(1, 0, At, B0); G_BAR; G_SCHED;
            G_STAGE(G_SB(1, 1), b3 + hstepB, voffB);
            G_WAIT_V(6); G_BAR; G_MMA(1, 1, At, B1); G_BAR;
        }
        epi(acc, cpm, cpn, wr, wc, fr, fq);
        if (!has_next) break;
#pragma unroll
        for (int a = 0; a < 2; ++a)
#pragma unroll
            for (int b = 0; b < 2; ++b)
#pragma unroll
                for (int m = 0; m < 4; ++m)
#pragma unroll
                    for (int n = 0; n < 2; ++n) acc[a][b][m][n] = (f32x4){0.f, 0.f, 0.f, 0.f};
        cpm = npm; cpn = npn; cA = nA; cB = nB; ++ui;
    }
    G_WAIT_V(0);
    if (wr == 0) G_BAR;
    G_BAR;
#undef G_SA
#undef G_SB
#undef G_STAGE
#undef G_LDA
#undef G_LDB
#undef G_MMA
#undef G_WAIT_V
#undef G_WAIT_L
#undef G_BAR
#undef G_SCHED
}

template <int ACT>
DI void epi_bf16(const f32x4 (&acc)[2][2][4][2], bf16_t* O, const int ldc, int wr, int wc, int fr, int fq, const float* ssrow = nullptr) {
#pragma unroll
    for (int ai = 0; ai < 2; ++ai)
#pragma unroll
        for (int m = 0; m < 4; ++m) {
            bf16_t* rowp = O + (size_t)(ai * HALF + wr * 64 + m * 16 + fr) * ldc + wc * 32 + 8 * fq;
            const float rsc = ssrow ? __builtin_amdgcn_rsqf(ssrow[ai * HALF + wr * 64 + m * 16 + fr] * (1.f / 1024.f) + EPS_) : 1.f;
#pragma unroll
            for (int bj = 0; bj < 2; ++bj) {
                f32x4 v0 = acc[ai][bj][m][0] * rsc, v1 = acc[ai][bj][m][1] * rsc;
                if (ACT == 1) {
#pragma unroll
                    for (int j = 0; j < 4; ++j) { v0[j] = silu_(v0[j]); v1[j] = silu_(v1[j]); } }
                if (ACT == 2) {
#pragma unroll
                    for (int j = 0; j < 4; ++j) { v0[j] = sigm(v0[j]); v1[j] = sigm(v1[j]); } }
                u32x4 w; w[0] = pk2(v0[0], v0[1]); w[1] = pk2(v0[2], v0[3]); w[2] = pk2(v1[0], v1[1]); w[3] = pk2(v1[2], v1[3]);
                *(u32x4*)(rowp + bj * HALF) = w;
            }
        }
}

DI void epi_zo(const f32x4 (&acc)[2][2][4][2], unsigned char* O, const int esz, int wr, int wc, int fr, int fq) {
#pragma unroll
    for (int ai = 0; ai < 2; ++ai)
#pragma unroll
        for (int m = 0; m < 4; ++m) {
            unsigned char* rowp = O + ((size_t)(ai * HALF + wr * 64 + m * 16 + fr) * 2048 + wc * 32 + 8 * fq) * esz;
#pragma unroll
            for (int bj = 0; bj < 2; ++bj) {
                const f32x4 v0 = acc[ai][bj][m][0], v1 = acc[ai][bj][m][1];
                if (esz == 2) { u32x4 w; w[0] = pk2(v0[0], v0[1]); w[1] = pk2(v0[2], v0[3]); w[2] = pk2(v1[0], v1[1]); w[3] = pk2(v1[2], v1[3]); *(u32x4*)(rowp + bj * HALF * 2) = w; }
                else { u32x2 w; w[0] = pk_fp8x4(v0[0], v0[1], v0[2], v0[3]); w[1] = pk_fp8x4(v1[0], v1[1], v1[2], v1[3]); *(u32x2*)(rowp + bj * HALF) = w; }
            }
        }
}

struct TJob { const float* src; bf16_t* dst; int lds_, srcb, K, N, ldd, dstb; float scale; const float* ks; };
DI TJob get_job(const Params& p, int j) {
    TJob t; unsigned char* ws = p.ws;
    switch (j) {
    case 0: t = TJob{p.in[3], (bf16_t*)(ws + WS_WT_XM), 6152, 0, 1024, 2048, 1024, 0, 1.f, nullptr}; break;
    case 1: t = TJob{p.in[3] + 2048, (bf16_t*)(ws + WS_WT_ZO), 6152, 0, 1024, 4096, 1024, 0, 1.f, nullptr}; break;
    case 2: t = TJob{p.in[6], (bf16_t*)(ws + WS_WT_QK), 256, 512 * 256, 512, 256, 512, 512 * 512, 0.0625f, nullptr}; break;
    case 3: t = TJob{p.in[7], (bf16_t*)(ws + WS_WT_QK) + 256 * 512, 256, 512 * 256, 512, 256, 512, 512 * 512, 1.f, nullptr}; break;
    case 4: t = TJob{p.in[8], (bf16_t*)(ws + WS_WT_V), 512, 512 * 512, 512, 512, 512, 512 * 512, 1.f, nullptr}; break;
    case 5: t = TJob{p.in[13], (bf16_t*)(ws + WS_WT_OUT0), 1024, 0, 2048, 1024, 2048, 0, 1.f, nullptr}; break;
    case 6: t = TJob{p.in[14], (bf16_t*)(ws + WS_WT_IN1), 3072, 0, 1024, 3072, 1024, 0, 1.f, p.in[1] + 1024}; break;
    default: t = TJob{p.in[22], (bf16_t*)(ws + WS_WT_OUT1), 1024, 0, 1536, 1024, 1536, 0, 1.f, nullptr}; break;
    }
    return t;
}

template <bool GATES>
DI void rmsnorm_rows(const float* X, const float* g, bf16_t* U, const float* Wg, const float* b_i, const float* b_f, float* LI, float* LF) {
    const int tid_ = opq(threadIdx.x), lane = tid_ & 63, wid = tid_ >> 6;
    const int gw = blockIdx.x * 8 + wid, nw = gridDim.x * 8;
    f32x4 g4[4];
#pragma unroll
    for (int i = 0; i < 4; ++i) g4[i] = ((const f32x4*)g)[lane + 64 * i];
    f32x4 nx[4];
#pragma unroll
    for (int i = 0; i < 4; ++i) nx[i] = ((const f32x4*)(X + (size_t)gw * 1024))[lane + 64 * i];
    for (int row = gw; row < T_; row += nw) {
        f32x4 v[4]; float ss = 0.f;
        const int rown = (row + nw < T_) ? row + nw : row;
#pragma unroll
        for (int i = 0; i < 4; ++i) { v[i] = nx[i]; nx[i] = ((const f32x4*)(X + (size_t)rown * 1024))[lane + 64 * i]; ss += v[i][0] * v[i][0] + v[i][1] * v[i][1] + v[i][2] * v[i][2] + v[i][3] * v[i][3]; }
        ss = wave_sum(ss);
        const float rs = __builtin_amdgcn_rsqf(ss * (1.f / 1024.f) + EPS_);
#pragma unroll
        for (int i = 0; i < 4; ++i) { v[i] = v[i] * rs * g4[i]; u32x2 w; w[0] = pk2(v[i][0], v[i][1]); w[1] = pk2(v[i][2], v[i][3]); ((u32x2*)(U + (size_t)row * 1024))[lane + 64 * i] = w; }
        if (GATES) {
            float d[8];
#pragma unroll
            for (int j = 0; j < 8; ++j) { float s = 0.f;
#pragma unroll
                for (int i = 0; i < 4; ++i) { const f32x4 w = ((const f32x4*)(Wg + j * 1024))[lane + 64 * i]; s += v[i][0] * w[0] + v[i][1] * w[1] + v[i][2] * w[2] + v[i][3] * w[3]; }
                d[j] = wave_sum(s); }
            float val = d[0];
#pragma unroll
            for (int j = 1; j < 8; ++j) val = (lane == j) ? d[j] : val;
            if (lane < 8) {
                const int b = row >> 11, s = row & 2047, hh = lane & 3;
                if (lane < 4) LI[(size_t)(b * 4 + hh) * S_ + s] = val + b_i[hh];
                else { const float xx = val + b_f[hh]; LF[(size_t)(b * 4 + hh) * S_ + s] = fminf(xx, 0.f) - log1pf(__expf(-fabsf(xx))); }
            }
        }
    }
}

DI void phase_prep(const Params& p, unsigned char* shm) {
    const int tid = opq(threadIdx.x);
    const size_t gtid = (size_t)blockIdx.x * 512 + tid, gsize = (size_t)gridDim.x * 512;
    float* tl = (float*)shm;
    float* Wg = (float*)(shm + 20480);
    for (int idx = tid; idx < 8192; idx += 512) { const int j = idx >> 10, k = idx & 1023; Wg[idx] = p.in[3][(size_t)k * 6152 + 6144 + j]; }
    for (int tile = blockIdx.x; tile < 3712; tile += gridDim.x) {
        int j, base;
        if (tile < 512) { j = 0; base = 0; } else if (tile < 1536) { j = 1; base = 512; } else if (tile < 1664) { j = 2; base = 1536; } else if (tile < 1792) { j = 3; base = 1664; }
        else if (tile < 2048) { j = 4; base = 1792; } else if (tile < 2560) { j = 5; base = 2048; } else if (tile < 3328) { j = 6; base = 2560; } else { j = 7; base = 3328; }
        const TJob jb = get_job(p, j);
        const int lt = tile - base, ntn = jb.N / 64, ntk = jb.K / 64;
        const int b = lt / (ntn * ntk), r = lt % (ntn * ntk), tk = r / ntn, tn = r % ntn;
        const float* src = jb.src + (size_t)b * jb.srcb + (size_t)(tk * 64) * jb.lds_ + tn * 64;
#pragma unroll
        for (int i = 0; i < 2; ++i) { const int kk = (tid >> 4) + 32 * i, c4 = (tid & 15) * 4; const f32x4 v = *(const f32x4*)(src + (size_t)kk * jb.lds_ + c4);
            const float sc = jb.ks ? jb.scale * jb.ks[tk * 64 + kk] : jb.scale;
            tl[kk * 65 + c4] = v[0] * sc; tl[kk * 65 + c4 + 1] = v[1] * sc; tl[kk * 65 + c4 + 2] = v[2] * sc; tl[kk * 65 + c4 + 3] = v[3] * sc; }
        __syncthreads();
        { const int n = tid >> 3, k8 = (tid & 7) * 8; float f[8];
#pragma unroll
          for (int e = 0; e < 8; ++e) f[e] = tl[(k8 + e) * 65 + n];
          *(u32x4*)(jb.dst + (size_t)b * jb.dstb + (size_t)(tn * 64 + n) * jb.ldd + tk * 64 + k8) = pack8f(f); }
        __syncthreads();
    }
    { bf16_t* WG = (bf16_t*)(p.ws + WS_WT_G);
      for (size_t idx = gtid; idx < (size_t)8 * 2 * 192 * 192; idx += gsize) {
          const int c = (int)(idx % 192), d = (int)((idx / 192) % 192), g = (int)((idx / 36864) & 1), blk = (int)(idx / 73728);
          const float v = (g ? p.in[19] : p.in[17])[(size_t)blk * 36864 + (size_t)c * 192 + d];
          WG[idx] = (bf16_t)(pk2(v, 0.f) & 0xffffu); } }
    { float* SS = (float*)(p.ws + WS_SS); float* SS1 = (float*)(p.ws + WS_SS1); for (size_t idx = gtid; idx < (size_t)T_; idx += gsize) { SS[idx] = 0.f; SS1[idx] = 0.f; } }
    { float* SP = (float*)(p.ws + WS_SP); for (size_t idx = gtid; idx < (size_t)1536; idx += gsize) SP[idx] = -8.f * log1pf(__expf(-p.in[21][idx])); }
    __syncthreads();
    rmsnorm_rows<true>(p.in[0], p.in[1], (bf16_t*)(p.ws + WS_U), Wg, p.in[9], p.in[10], (float*)(p.ws + WS_LI), (float*)(p.ws + WS_LF));
}

template <int CIN, int COUT, bool SILU>
DI void conv_phase(const bf16_t* X, const float* w, const float* bias, bf16_t* Y) {
    constexpr int NG = COUT / 8, NGV = CIN / 8;
    const int total = (T_ / 16) * NG;
    for (int it = blockIdx.x * 512 + opq(threadIdx.x); it < total; it += gridDim.x * 512) {
        const int cgp = it % NG, tc = it / NG, t0 = tc * 16;
        if (cgp >= NGV) {
            for (int r = 0; r < 16; ++r) *(u32x4*)(Y + (size_t)(t0 + r) * COUT + cgp * 8) = (u32x4){0u, 0u, 0u, 0u};
            continue;
        }
        const int c0 = cgp * 8;
        float w0[8], w1[8], w2[8], w3[8], bb[8], p3[8], p2[8], p1[8];
#pragma unroll
        for (int e = 0; e < 8; ++e) { w0[e] = w[c0 + e]; w1[e] = w[CIN + c0 + e]; w2[e] = w[2 * CIN + c0 + e]; w3[e] = w[3 * CIN + c0 + e]; bb[e] = bias[c0 + e]; }
        if ((t0 & 2047) == 0) {
#pragma unroll
            for (int e = 0; e < 8; ++e) { p3[e] = 0.f; p2[e] = 0.f; p1[e] = 0.f; }
        } else {
            unpack8(*(const u32x4*)(X + (size_t)(t0 - 3) * CIN + c0), p3);
            unpack8(*(const u32x4*)(X + (size_t)(t0 - 2) * CIN + c0), p2);
            unpack8(*(const u32x4*)(X + (size_t)(t0 - 1) * CIN + c0), p1);
        }
#pragma unroll
        for (int r = 0; r < 16; ++r) {
            float cur[8], y[8];
            unpack8(*(const u32x4*)(X + (size_t)(t0 + r) * CIN + c0), cur);
#pragma unroll
            for (int e = 0; e < 8; ++e) { float v = bb[e] + w0[e] * p3[e] + w1[e] * p2[e] + w2[e] * p1[e] + w3[e] * cur[e]; y[e] = SILU ? silu_(v) : v; p3[e] = p2[e]; p2[e] = p1[e]; p1[e] = cur[e]; }
            *(u32x4*)(Y + (size_t)(t0 + r) * COUT + c0) = pack8f(y);
        }
    }
}

DI void conv0_phase(const bf16_t* X, const float* w, const float* bias, bf16_t* Y) {
    const int gt = blockIdx.x * 512 + opq(threadIdx.x), stride = gridDim.x * 512;
    const int c0 = (gt & 255) * 8;
    float w0[8], w1[8], w2[8], w3[8], bb[8];
#pragma unroll
    for (int e = 0; e < 8; ++e) { w0[e] = w[c0 + e]; w1[e] = w[2048 + c0 + e]; w2[e] = w[4096 + c0 + e]; w3[e] = w[6144 + c0 + e]; bb[e] = bias[c0 + e]; }
    const int total = (T_ / 16) * 256;
    u32x4 nx[19];
    if (gt < total) {
        const int t0 = (gt >> 8) * 16; const bool first = (t0 & 2047) == 0;
#pragma unroll
        for (int r = 0; r < 19; ++r) { const int t = (first && r < 3) ? t0 : t0 - 3 + r; nx[r] = *(const u32x4*)(X + (size_t)t * 2048 + c0); }
    }
    for (int it = gt; it < total; it += stride) {
        const int t0 = (it >> 8) * 16; const bool first = (t0 & 2047) == 0;
        u32x4 cu[19];
#pragma unroll
        for (int r = 0; r < 19; ++r) cu[r] = nx[r];
        if (it + stride < total) {
            const int t1 = ((it + stride) >> 8) * 16; const bool f1 = (t1 & 2047) == 0;
#pragma unroll
            for (int r = 0; r < 19; ++r) { const int t = (f1 && r < 3) ? t1 : t1 - 3 + r; nx[r] = *(const u32x4*)(X + (size_t)t * 2048 + c0); }
        }
        float p3[8], p2[8], p1[8];
        unpack8(cu[0], p3); unpack8(cu[1], p2); unpack8(cu[2], p1);
        if (first) {
#pragma unroll
            for (int e = 0; e < 8; ++e) { p3[e] = 0.f; p2[e] = 0.f; p1[e] = 0.f; }
        }
#pragma unroll
        for (int r = 0; r < 16; ++r) {
            float cur[8], y[8];
            unpack8(cu[3 + r], cur);
#pragma unroll
            for (int e = 0; e < 8; ++e) { const float v = bb[e] + w0[e] * p3[e] + w1[e] * p2[e] + w2[e] * p1[e] + w3[e] * cur[e]; y[e] = silu_(v); p3[e] = p2[e]; p2[e] = p1[e]; p1[e] = cur[e]; }
            *(u32x4*)(Y + (size_t)(t0 + r) * 2048 + c0) = pack8f(y);
        }
    }
}

DI void gate_scan(const Params& p) {
    const int tid_ = opq(threadIdx.x), lane = tid_ & 63, wid = tid_ >> 6;
    const int bh = blockIdx.x * 8 + wid;
    if (bh >= 128) return;
    const float* LI = (const float*)(p.ws + WS_LI); const float* LF = (const float*)(p.ws + WS_LF);
    float* GP = (float*)(p.ws + WS_GP); float* GQ = (float*)(p.ws + WS_GQ); float* GD = (float*)(p.ws + WS_GD); float* GF = (float*)(p.ws + WS_GF); float* GW = (float*)(p.ws + WS_GW);
    float mcar = 0.f;
    float lfn = LF[(size_t)bh * S_ + lane], lin = LI[(size_t)bh * S_ + lane];
    for (int c = 0; c < 32; ++c) {
        const size_t o = (size_t)bh * S_ + c * 64 + lane;
        const float lf = lfn, li = lin;
        { const size_t on = (c < 31) ? o + 64 : o; lfn = LF[on]; lin = LI[on]; }
        float F = lf;
        F += __int_as_float(__builtin_amdgcn_update_dpp(0, __float_as_int(F), 0x111, 0xf, 0xf, false));
        F += __int_as_float(__builtin_amdgcn_update_dpp(0, __float_as_int(F), 0x112, 0xf, 0xf, false));
        F += __int_as_float(__builtin_amdgcn_update_dpp(0, __float_as_int(F), 0x114, 0xf, 0xf, false));
        F += __int_as_float(__builtin_amdgcn_update_dpp(0, __float_as_int(F), 0x118, 0xf, 0xf, false));
        { const int fi = __float_as_int(F); const float t0 = __int_as_float(__builtin_amdgcn_readlane(fi, 15)), t1 = __int_as_float(__builtin_amdgcn_readlane(fi, 31)), t2 = __int_as_float(__builtin_amdgcn_readlane(fi, 47));
          const int rw = lane >> 4; F += (rw >= 1 ? t0 : 0.f) + (rw >= 2 ? t1 : 0.f) + (rw >= 3 ? t2 : 0.f); }
        const float Qs = li - F;
        float Mx = Qs;
        { const int ninf = __float_as_int(-__builtin_inff());
          Mx = fmaxf(Mx, __int_as_float(__builtin_amdgcn_update_dpp(ninf, __float_as_int(Mx), 0x111, 0xf, 0xf, false)));
          Mx = fmaxf(Mx, __int_as_float(__builtin_amdgcn_update_dpp(ninf, __float_as_int(Mx), 0x112, 0xf, 0xf, false)));
          Mx = fmaxf(Mx, __int_as_float(__builtin_amdgcn_update_dpp(ninf, __float_as_int(Mx), 0x114, 0xf, 0xf, false)));
          Mx = fmaxf(Mx, __int_as_float(__builtin_amdgcn_update_dpp(ninf, __float_as_int(Mx), 0x118, 0xf, 0xf, false)));
          const int mi = __float_as_int(Mx); const float t0 = __int_as_float(__builtin_amdgcn_readlane(mi, 15)), t1 = __int_as_float(__builtin_amdgcn_readlane(mi, 31)), t2 = __int_as_float(__builtin_amdgcn_readlane(mi, 47));
          const int rw = lane >> 4; const float ninff = -__builtin_inff();
          Mx = fmaxf(Mx, fmaxf(fmaxf(rw >= 1 ? t0 : ninff, rw >= 2 ? t1 : ninff), rw >= 3 ? t2 : ninff)); }
        const float a = F + mcar, mt = fmaxf(a, F + Mx);
        const float P = F - mt;
        const float P63 = __int_as_float(__builtin_amdgcn_readlane(__float_as_int(P), 63));
        GP[o] = P; GQ[o] = Qs; GD[o] = __expf(a - mt); GF[o] = __expf(-mt); GW[o] = __expf(P63 + Qs);
        mcar = __int_as_float(__builtin_amdgcn_readlane(__float_as_int(mt), 63));
    }
}

template <int ST> DI bf16x8 pack_step(const f32x16& x) {
    u32x4 r; r[0] = pk2(x[8 * ST], x[8 * ST + 1]); r[1] = pk2(x[8 * ST + 2], x[8 * ST + 3]); r[2] = pk2(x[8 * ST + 4], x[8 * ST + 5]); r[3] = pk2(x[8 * ST + 6], x[8 * ST + 7]);
    return __builtin_bit_cast(bf16x8, r);
}
DI bf16x8 join4(const s16x4& lo, const s16x4& hi) { return __builtin_shufflevector(lo, hi, 0, 1, 2, 3, 4, 5, 6, 7); }
#define MFMA32(a, b, c) __builtin_amdgcn_mfma_f32_32x32x16_bf16((a), (b), (c), 0, 0, 0)
#define TRRD(ptr) __builtin_amdgcn_ds_read_tr16_b64_v4i16((LAS s16x4*)(ptr))

DI void phase_mlstm(const Params& p, unsigned char* shm) {
    LAS unsigned char* lds = (LAS unsigned char*)shm;
    constexpr int RS = 528, QI = 0, KI = 64 * RS, VI = KI + 80 * RS, SMI = VI + 64 * RS, SMS = 144;
    constexpr int NS = SMI + 64 * SMS, NACC = NS + 1024, QN = NACC + 1024, RSUM = QN + 256, PC = RSUM + 256, QC = PC + 256, DEC = QC + 256, FLR = DEC + 256, WL = FLR + 256;
    constexpr int PNB = WL + 256;
    static_assert(PNB + 16384 <= LDS_BYTES - 64, "lds");
    const int w = __builtin_amdgcn_readfirstlane(threadIdx.x >> 6);
    const bf16_t* Q = (const bf16_t*)p.out; const bf16_t* Kp = Q + (size_t)T_ * 1024; const bf16_t* V = (const bf16_t*)(p.ws + WS_RC);
    bf16_t* H = (bf16_t*)(p.ws + WS_RA);
    const float* GP = (const float*)(p.ws + WS_GP); const float* GQ = (const float*)(p.ws + WS_GQ); const float* GD = (const float*)(p.ws + WS_GD);
    const float* GF = (const float*)(p.ws + WS_GF); const float* GW = (const float*)(p.ws + WS_GW);
    LAS float* n_s = (LAS float*)(lds + NS); LAS float* nacc = (LAS float*)(lds + NACC); LAS float* qn = (LAS float*)(lds + QN); LAS float* rsum = (LAS float*)(lds + RSUM);
    LAS float* wls = (LAS float*)(lds + WL);
    LAS float* Pc = (LAS float*)(lds + PC); LAS float* Qc = (LAS float*)(lds + QC); LAS float* dec = (LAS float*)(lds + DEC); LAS float* flr = (LAS float*)(lds + FLR);
    for (int unit = blockIdx.x; unit < 256; unit += gridDim.x) {
        const int bh = (unit & 7) * 16 + (unit >> 4), half = (unit >> 3) & 1, b = bh >> 2, h = bh & 3;
        f32x16 C[8];
        unsigned pf0 = 0u, pf1 = 0u;
#pragma unroll
        for (int i = 0; i < 8; ++i)
#pragma unroll
            for (int e = 0; e < 16; ++e) C[i][e] = 0.f;
        if (threadIdx.x < 256) { n_s[threadIdx.x] = 0.f; nacc[threadIdx.x] = 0.f; }
        { const int tid = threadIdx.x; if (tid < 480) *(LAS u32x4*)(lds + KI + (65 + (tid >> 5)) * RS + 16 * (tid & 31)) = (u32x4){0u, 0u, 0u, 0u}; }
        for (int c = 0; c < 32; ++c) {
            __syncthreads();
            asm volatile("" :: "v"(pf0), "v"(pf1));
            const int t0 = b * S_ + c * 64; const size_t gbase = (size_t)bh * S_ + c * 64;
            {
                const int tid = opq(threadIdx.x), r4 = tid >> 5, cgp = tid & 31;
                if (tid < 64) { Pc[tid] = GP[gbase + tid]; Qc[tid] = GQ[gbase + tid]; dec[tid] = GD[gbase + tid]; flr[tid] = GF[gbase + tid]; wls[tid] = GW[gbase + tid]; rsum[tid] = 0.f; }
                float pn[8];
#pragma unroll
                for (int e = 0; e < 8; ++e) pn[e] = 0.f;
                if (tid < 32) {
                    const f32x4 n0 = *(const LAS f32x4*)(n_s + 8 * cgp), n1 = *(const LAS f32x4*)(n_s + 8 * cgp + 4);
                    u32x4 nb; nb[0] = pk2(n0[0], n0[1]); nb[1] = pk2(n0[2], n0[3]); nb[2] = pk2(n1[0], n1[1]); nb[3] = pk2(n1[2], n1[3]);
                    *(LAS u32x4*)(lds + KI + 64 * RS + 16 * cgp) = nb;
                }
                const bf16_t* qp = Q + (size_t)(t0 + r4) * 1024 + h * 256 + 8 * cgp;
                const bf16_t* kp = Kp + (size_t)(t0 + r4) * 1024 + h * 256 + 8 * cgp;
                const bf16_t* vp = V + (size_t)(t0 + r4) * 2048 + h * 512 + half * 256 + 8 * cgp;
                const int lo_ = r4 * RS + 16 * cgp;
#pragma unroll
                for (int i = 0; i < 4; ++i) {
                    const u32x4 qv = *(const u32x4*)(qp + (size_t)i * 16 * 1024);
                    const u32x4 kv = *(const u32x4*)(kp + (size_t)i * 16 * 1024);
                    const u32x4 vv = *(const u32x4*)(vp + (size_t)i * 16 * 2048);
                    const float wl = GW[gbase + r4 + 16 * i];
                    *(LAS u32x4*)(lds + QI + lo_ + i * 16 * RS) = qv;
                    *(LAS u32x4*)(lds + KI + lo_ + i * 16 * RS) = kv;
                    *(LAS u32x4*)(lds + VI + lo_ + i * 16 * RS) = vv;
                    float f[8];
                    unpack8(kv, f);
#pragma unroll
                    for (int e = 0; e < 8; ++e) pn[e] += wl * f[e];
                }
                *(LAS f32x4*)(lds + PNB + r4 * 1024 + cgp * 32) = (f32x4){pn[0], pn[1], pn[2], pn[3]};
                *(LAS f32x4*)(lds + PNB + r4 * 1024 + cgp * 32 + 16) = (f32x4){pn[4], pn[5], pn[6], pn[7]};
            }
            __syncthreads();
            if (c < 31) {
                const int tid = opq(threadIdx.x), rr = (tid & 255) >> 2, sg = tid & 3;
                const bf16_t* qk = (tid < 256 ? Q : Kp) + (size_t)(t0 + 64 + rr) * 1024 + h * 256 + sg * 64;
                pf0 = *(const unsigned*)qk;
                if (tid < 256) pf1 = *(const unsigned*)(V + (size_t)(t0 + 64 + rr) * 2048 + h * 512 + half * 256 + sg * 64);
            }
            const float d_last = dec[63];
            if (threadIdx.x < 256) { const int tid = threadIdx.x; float a = 0.f;
#pragma unroll
                for (int g = 0; g < 16; ++g) a += *(const LAS float*)(lds + PNB + g * 1024 + tid * 4);
                n_s[tid] = d_last * n_s[tid] + a; }
            {
                const int lane = opq(threadIdx.x) & 63, fr = lane & 15, fq = lane >> 4;
                const int ti = w & 3;
#pragma unroll
                for (int z = 0; z < 2; ++z) {
                    const int si = 2 * (w >> 2) + z;
                    f32x4 a4 = {0.f, 0.f, 0.f, 0.f};
                    if (si <= ti) {
                        const int ka = KI + (16 * si + fr) * RS + 16 * fq, qa = QI + (16 * ti + fr) * RS + 16 * fq;
#pragma unroll
                        for (int kk = 0; kk < 8; ++kk) {
                            const bf16x8 af = *(const LAS bf16x8*)(lds + ka + 64 * kk);
                            const bf16x8 bq = *(const LAS bf16x8*)(lds + qa + 64 * kk);
                            a4 = __builtin_amdgcn_mfma_f32_16x16x32_bf16(af, bq, a4, 0, 0, 0);
                        }
                        const int t = 16 * ti + fr; const float Pt = Pc[t];
                        const f32x4 qs = *(const LAS f32x4*)(Qc + 16 * si + 4 * fq);
                        float rsm = 0.f;
#pragma unroll
                        for (int j = 0; j < 4; ++j) { const int s = 16 * si + 4 * fq + j; const float wg = (s <= t) ? __expf(Pt + qs[j]) : 0.f; a4[j] *= wg; rsm += a4[j]; }
                        rsm += __shfl_xor(rsm, 16); rsm += __shfl_xor(rsm, 32);
                        if (fq == 0) __hip_atomic_fetch_add((float*)(shm + RSUM) + t, rsm, __ATOMIC_RELAXED, __HIP_MEMORY_SCOPE_WORKGROUP);
                    }
                    u32x2 sm; sm[0] = pk2(a4[0], a4[1]); sm[1] = pk2(a4[2], a4[3]);
                    *(LAS u32x2*)(lds + SMI + (16 * ti + fr) * SMS + (16 * si + 4 * fq) * 2) = sm;
                }
                if (w == 4 || w == 5) {
#pragma unroll
                    for (int z = 0; z < 2; ++z) {
                        const int tn = 2 * (w - 4) + z;
                        const int ka = KI + (64 + fr) * RS + 16 * fq, qa = QI + (16 * tn + fr) * RS + 16 * fq;
                        f32x4 a4 = {0.f, 0.f, 0.f, 0.f};
#pragma unroll
                        for (int kk = 0; kk < 8; ++kk) {
                            const bf16x8 af = *(const LAS bf16x8*)(lds + ka + 64 * kk);
                            const bf16x8 bq = *(const LAS bf16x8*)(lds + qa + 64 * kk);
                            a4 = __builtin_amdgcn_mfma_f32_16x16x32_bf16(af, bq, a4, 0, 0, 0);
                        }
                        if (fq == 0) qn[16 * tn + fr] = a4[0];
                    }
                }
            }
            __builtin_amdgcn_sched_barrier(0);
            f32x16 acc2[2];
#pragma unroll
            for (int m = 0; m < 2; ++m)
#pragma unroll
                for (int e = 0; e < 16; ++e) acc2[m][e] = 0.f;
            {
                const int lane = opq(threadIdx.x) & 63, l32 = lane & 31, hh = lane >> 5;
                const int qb = QI + l32 * RS + 8 * hh;
#pragma unroll
                for (int ci = 0; ci < 8; ++ci) {
                    s16x4 lo[2][2], hi[2][2];
#pragma unroll
                    for (int st = 0; st < 2; ++st)
#pragma unroll
                        for (int m2 = 0; m2 < 2; ++m2) { const int off = qb + 32 * m2 * RS + 64 * ci + 32 * st;
                            lo[st][m2] = *(const LAS s16x4*)(lds + off); hi[st][m2] = *(const LAS s16x4*)(lds + off + 16); }
                    const bf16x8 bf0 = pack_step<0>(C[ci]), bf1 = pack_step<1>(C[ci]);
                    __builtin_amdgcn_sched_barrier(0);
#pragma unroll
                    for (int m2 = 0; m2 < 2; ++m2) acc2[m2] = MFMA32(join4(lo[0][m2], hi[0][m2]), bf0, acc2[m2]);
#pragma unroll
                    for (int m2 = 0; m2 < 2; ++m2) acc2[m2] = MFMA32(join4(lo[1][m2], hi[1][m2]), bf1, acc2[m2]);
                    __builtin_amdgcn_sched_barrier(0);
                }
            }
            __syncthreads();
            {
                const int lane = opq(threadIdx.x) & 63, l32 = lane & 31, hh = lane >> 5, q4 = (lane & 15) >> 2, p4 = lane & 3, blk = (lane >> 4) & 1;
#pragma unroll
                for (int m = 0; m < 2; ++m)
#pragma unroll
                    for (int g = 0; g < 4; ++g) { const f32x4 d4 = *(const LAS f32x4*)(dec + 32 * m + 8 * g + 4 * hh);
#pragma unroll
                        for (int e = 0; e < 4; ++e) acc2[m][4 * g + e] *= d4[e]; }
                const int vb = VI + (8 * hh + q4) * RS + (32 * w + 16 * blk) * 2 + 8 * p4, sb = SMI + l32 * SMS + 16 * hh;
#pragma unroll
                for (int kk = 0; kk < 4; ++kk) {
                    const s16x4 lo = TRRD(lds + vb + 16 * kk * RS), hi = TRRD(lds + vb + 16 * kk * RS + 4 * RS);
                    const bf16x8 bf = join4(lo, hi);
#pragma unroll
                    for (int m = 0; m < 2; ++m) { const bf16x8 af = *(const LAS bf16x8*)(lds + sb + 32 * m * SMS + 32 * kk); acc2[m] = MFMA32(af, bf, acc2[m]); }
                }
                const int hb = QI + 4 * hh * RS + (32 * w + l32) * 2;
#pragma unroll
                for (int m = 0; m < 2; ++m)
#pragma unroll
                    for (int g = 0; g < 4; ++g) {
                        const int rb = 32 * m + 8 * g;
                        const f32x4 d4 = *(const LAS f32x4*)(dec + rb + 4 * hh), n4 = *(const LAS f32x4*)(qn + rb + 4 * hh), s4 = *(const LAS f32x4*)(rsum + rb + 4 * hh), f4 = *(const LAS f32x4*)(flr + rb + 4 * hh);
#pragma unroll
                        for (int e = 0; e < 4; ++e) {
                            const float den = d4[e] * n4[e] + s4[e];
                            const float val = acc2[m][4 * g + e] * __builtin_amdgcn_rcpf(fmaxf(fabsf(den), f4[e]));
                            *(LAS bf16_t*)(lds + hb + (rb + e) * RS) = (bf16_t)(pk2(val, 0.f) & 0xffffu);
                        }
                    }
            }
            __builtin_amdgcn_sched_barrier(0);
            {
                const int lane = opq(threadIdx.x) & 63, hh = lane >> 5, q4 = (lane & 15) >> 2, p4 = lane & 3, blk = (lane >> 4) & 1;
                const int tb = (8 * hh + q4) * RS + 32 * blk + 8 * p4;
                bf16x8 bw[4];
#pragma unroll
                for (int kk = 0; kk < 4; ++kk) { const int voff = VI + tb + 64 * w + 16 * kk * RS;
                    const bf16x8 raw = join4(TRRD(lds + voff), TRRD(lds + voff + 4 * RS));
                    const f32x4 w0 = *(const LAS f32x4*)(wls + 16 * kk + 8 * hh), w1 = *(const LAS f32x4*)(wls + 16 * kk + 8 * hh + 4);
                    float f[8]; unpack8(__builtin_bit_cast(u32x4, raw), f);
#pragma unroll
                    for (int e = 0; e < 4; ++e) { f[e] *= w0[e]; f[4 + e] *= w1[e]; }
                    bw[kk] = __builtin_bit_cast(bf16x8, pack8f(f)); }
#pragma unroll
                for (int ci = 0; ci < 8; ++ci) {
                    bf16x8 ka[4];
#pragma unroll
                    for (int kk = 0; kk < 4; ++kk) { const int koff = KI + tb + 64 * ci + 16 * kk * RS; ka[kk] = join4(TRRD(lds + koff), TRRD(lds + koff + 4 * RS)); }
#pragma unroll
                    for (int e = 0; e < 16; ++e) C[ci][e] *= d_last;
                    __builtin_amdgcn_sched_barrier(0);
#pragma unroll
                    for (int kk = 0; kk < 4; ++kk) C[ci] = MFMA32(ka[kk], bw[kk], C[ci]);
                    __builtin_amdgcn_sched_barrier(0);
                }
            }
            __syncthreads();
            {
                const int tid = opq(threadIdx.x), r4 = tid >> 5, cgp = tid & 31;
                bf16_t* hp = H + (size_t)(t0 + r4) * 2048 + h * 512 + half * 256 + 8 * cgp;
#pragma unroll
                for (int i = 0; i < 4; ++i) *(u32x4*)(hp + (size_t)i * 16 * 2048) = *(const LAS u32x4*)(lds + QI + (r4 + 16 * i) * RS + 16 * cgp);
            }
        }
        __syncthreads();
    }
}


DI void phase_post(const Params& p) {
    const int tid_ = opq(threadIdx.x), lane = tid_ & 63, wid = tid_ >> 6;
    const int gw = blockIdx.x * 8 + wid, nw = gridDim.x * 8;
    bf16_t* H = (bf16_t*)(p.ws + WS_RA); const unsigned char* O = (const unsigned char*)p.out; const bf16_t* XC = (const bf16_t*)(p.ws + WS_RB); const bf16_t* Z = (const bf16_t*)(p.ws + WS_RC);
    const float* nwp = p.in[11]; const float* skp = p.in[12];
    u32x4 nh, nx, nz; u32x2 no;
    { const size_t b0 = (size_t)(gw >> 2) * 2048 + (gw & 3) * 512 + lane * 8; nh = *(const u32x4*)(H + b0); no = *(const u32x2*)(O + b0); nx = *(const u32x4*)(XC + b0); nz = *(const u32x4*)(Z + b0); }
    for (int u = gw; u < T_ * 4; u += nw) {
        const int hd = u & 3; const size_t base = (size_t)(u >> 2) * 2048 + hd * 512 + lane * 8;
        float hv[8], ov[8], xv[8], zv[8];
        unpack8(nh, hv); unpack_fp8x8(no, ov); unpack8(nx, xv); unpack8(nz, zv);
        { const int un = (u + nw < T_ * 4) ? u + nw : u; const size_t bn = (size_t)(un >> 2) * 2048 + (un & 3) * 512 + lane * 8;
          nh = *(const u32x4*)(H + bn); no = *(const u32x2*)(O + bn); nx = *(const u32x4*)(XC + bn); nz = *(const u32x4*)(Z + bn); }
        float s = 0.f;
#pragma unroll
        for (int e = 0; e < 8; ++e) { hv[e] *= sigm(ov[e]); s += hv[e]; }
        const float mu = wave_sum(s) * (1.f / 512.f);
        float s2 = 0.f;
#pragma unroll
        for (int e = 0; e < 8; ++e) { hv[e] -= mu; s2 += hv[e] * hv[e]; }
        const float r = __builtin_amdgcn_rsqf(wave_sum(s2) * (1.f / 512.f) + EPS_);
        const f32x4 nw0 = *(const f32x4*)(nwp + hd * 512 + lane * 8), nw1 = *(const f32x4*)(nwp + hd * 512 + lane * 8 + 4);
        const f32x4 sk0 = *(const f32x4*)(skp + hd * 512 + lane * 8), sk1 = *(const f32x4*)(skp + hd * 512 + lane * 8 + 4);
        float y[8];
#pragma unroll
        for (int e = 0; e < 4; ++e) { y[e] = (hv[e] * r * nw0[e] + sk0[e] * xv[e]) * silu_(zv[e]); y[4 + e] = (hv[4 + e] * r * nw1[e] + sk1[e] * xv[4 + e]) * silu_(zv[4 + e]); }
        *(u32x4*)(H + base) = pack8f(y);
    }
}

DI void phase_scan(const Params& p, unsigned char* shm) {
    LAS unsigned char* lds = (LAS unsigned char*)shm;
    constexpr int TR = 400, TSZ = 64 * TR;
    const bf16_t* LA = (const bf16_t*)(p.ws + WS_LA); const bf16_t* BT = (const bf16_t*)(p.ws + WS_BT); const bf16_t* G = (const bf16_t*)(p.ws + WS_RC);
    bf16_t* Y = (bf16_t*)(p.ws + WS_RB);
    const int tid = opq(threadIdx.x);
    for (int unit = blockIdx.x; unit < 256; unit += gridDim.x) {
        const int b = unit >> 3, cg0 = (unit & 7) * 192;
        int goff[3], loff[3];
#pragma unroll
        for (int j = 0; j < 3; ++j) { const int q = tid + 512 * j, row = q / 24, cc = q % 24; goff[j] = row * 1536 + cc * 8; loff[j] = row * TR + cc * 16; }
        const size_t base = (size_t)b * S_ * 1536 + cg0;
        u32x4 ra[3], rb[3], rg[3];
#pragma unroll
        for (int j = 0; j < 3; ++j) { ra[j] = *(const u32x4*)(LA + base + goff[j]); rb[j] = *(const u32x4*)(BT + base + goff[j]); rg[j] = *(const u32x4*)(G + base + goff[j]); }
        float hst = 0.f;
        for (int tile = 0; tile < 32; ++tile) {
            __syncthreads();
#pragma unroll
            for (int j = 0; j < 3; ++j) { *(LAS u32x4*)(lds + loff[j]) = ra[j]; *(LAS u32x4*)(lds + TSZ + loff[j]) = rb[j]; *(LAS u32x4*)(lds + 2 * TSZ + loff[j]) = rg[j]; }
            if (tile < 31) {
                const size_t nb = base + (size_t)(tile + 1) * 64 * 1536;
#pragma unroll
                for (int j = 0; j < 3; ++j) { ra[j] = *(const u32x4*)(LA + nb + goff[j]); rb[j] = *(const u32x4*)(BT + nb + goff[j]); rg[j] = *(const u32x4*)(G + nb + goff[j]); }
            }
            __syncthreads();
            if (tid < 192) {
#pragma unroll 8
                for (int r = 0; r < 64; ++r) {
                    const float la = __uint_as_float((unsigned)*(const LAS bf16_t*)(lds + r * TR + tid * 2) << 16);
                    const float bt = __uint_as_float((unsigned)*(const LAS bf16_t*)(lds + TSZ + r * TR + tid * 2) << 16);
                    const float g = __uint_as_float((unsigned)*(const LAS bf16_t*)(lds + 2 * TSZ + r * TR + tid * 2) << 16);
                    hst = __expf(la) * hst + bt;
                    *(LAS bf16_t*)(lds + 2 * TSZ + r * TR + tid * 2) = (bf16_t)(pk2(hst * g, 0.f) & 0xffffu);
                }
            }
            __syncthreads();
            const size_t ob = base + (size_t)tile * 64 * 1536;
#pragma unroll
            for (int j = 0; j < 3; ++j) *(u32x4*)(Y + ob + goff[j]) = *(const LAS u32x4*)(lds + 2 * TSZ + loff[j]);
        }
        __syncthreads();
    }
}

DI void phase_rglru(const Params& p, unsigned char* shm) {
    LAS unsigned char* lds = (LAS unsigned char*)shm;
    constexpr int TR = 400, XR = 0, XC = 26880, GT = XC + 25600, LAo = GT + 25600, BTo = LAo + 25600, CW = BTo + 25600, GB = CW + 3840;
    static_assert(GB + 2304 <= LDS_BYTES, "lds");
    const int tid = opq(threadIdx.x), lane = tid & 63, w = __builtin_amdgcn_readfirstlane(tid >> 6), fr = lane & 15, fq = lane >> 4;
    const bf16_t* XRg = (const bf16_t*)(p.ws + WS_RA); const bf16_t* Gg = (const bf16_t*)(p.ws + WS_RC); bf16_t* Y = (bf16_t*)(p.ws + WS_RB);
    const bf16_t* WG2 = (const bf16_t*)(p.ws + WS_WT_G); const float* SPp = (const float*)(p.ws + WS_SP);
    LAS float* cw = (LAS float*)(lds + CW); LAS float* gb = (LAS float*)(lds + GB);
    for (int unit = blockIdx.x; unit < 256; unit += gridDim.x) {
        const int b = unit >> 3, blk = unit & 7, cg0 = blk * 192;
        __syncthreads();
        for (int i = tid; i < 960; i += 512) { const int j = i / 192, c = i % 192; cw[i] = j < 4 ? p.in[15][j * 1536 + cg0 + c] : p.in[16][cg0 + c]; }
        for (int i = tid; i < 576; i += 512) { const int k = i / 192, c = i % 192; gb[i] = (k == 0 ? p.in[18] : (k == 1 ? p.in[20] : SPp))[cg0 + c]; }
        if (tid < 72) *(LAS u32x4*)(lds + XR + (tid / 24) * TR + (tid % 24) * 16) = (u32x4){0u, 0u, 0u, 0u};
        bf16x8 Bf[4][6];
        const int chb = w < 4 ? 32 * w : 128 + 16 * (w - 4);
        {
#pragma unroll
          for (int nt = 0; nt < 4; ++nt)
#pragma unroll
              for (int kk = 0; kk < 6; ++kk) {
                  const int chn = chb + ((w < 4) ? 16 * (nt & 1) : 0) + fr;
                  Bf[nt][kk] = *(const bf16x8*)(WG2 + ((size_t)((blk * 2 + (nt >> 1)) * 192 + chn) * 192 + 32 * kk + 8 * fq)); } }
        int goff[3], loff[3];
#pragma unroll
        for (int j = 0; j < 3; ++j) { const int q = tid + 512 * j, row = q / 24, cc = q % 24; goff[j] = row * 1536 + cc * 8; loff[j] = row * TR + cc * 16; }
        const size_t base = (size_t)b * S_ * 1536 + cg0;
        u32x4 rx[3], rg[3];
#pragma unroll
        for (int j = 0; j < 3; ++j) { rx[j] = *(const u32x4*)(XRg + base + goff[j]); rg[j] = *(const u32x4*)(Gg + base + goff[j]); }
        float hst = 0.f;
        for (int tile = 0; tile < 32; ++tile) {
            __syncthreads();
#pragma unroll
            for (int j = 0; j < 3; ++j) { *(LAS u32x4*)(lds + XR + 3 * TR + loff[j]) = rx[j]; *(LAS u32x4*)(lds + GT + loff[j]) = rg[j]; }
            if (tile < 31) {
                const size_t nb = base + (size_t)(tile + 1) * 64 * 1536;
#pragma unroll
                for (int j = 0; j < 3; ++j) { rx[j] = *(const u32x4*)(XRg + nb + goff[j]); rg[j] = *(const u32x4*)(Gg + nb + goff[j]); }
            }
            __syncthreads();
#pragma unroll
            for (int j = 0; j < 3; ++j) {
                const int q = tid + 512 * j, cc = q % 24;
                float a8[8];
                { const f32x4 b0 = *(const LAS f32x4*)(cw + 768 + 8 * cc), b1 = *(const LAS f32x4*)(cw + 768 + 8 * cc + 4);
#pragma unroll
                  for (int e = 0; e < 4; ++e) { a8[e] = b0[e]; a8[4 + e] = b1[e]; } }
#pragma unroll
                for (int jj = 0; jj < 4; ++jj) {
                    float xin[8]; { const u32x4 xraw = *(const LAS u32x4*)(lds + XR + jj * TR + loff[j]); unpack8(xraw, xin); }
                    const f32x4 w0 = *(const LAS f32x4*)(cw + jj * 192 + 8 * cc), w1 = *(const LAS f32x4*)(cw + jj * 192 + 8 * cc + 4);
#pragma unroll
                    for (int e = 0; e < 4; ++e) { a8[e] += w0[e] * xin[e]; a8[4 + e] += w1[e] * xin[4 + e]; }
                }
                *(LAS u32x4*)(lds + XC + loff[j]) = pack8f(a8);
            }
            __syncthreads();
            {
#pragma unroll
                for (int u = 0; u < 2; ++u) {
                    if (u == 1 && w >= 4) break;
                    f32x4 acc[4][2];
#pragma unroll
                    for (int mt = 0; mt < 4; ++mt) { acc[mt][0] = (f32x4){0.f, 0.f, 0.f, 0.f}; acc[mt][1] = (f32x4){0.f, 0.f, 0.f, 0.f}; }
#pragma unroll
                    for (int kk = 0; kk < 6; ++kk)
#pragma unroll
                        for (int mt = 0; mt < 4; ++mt) {
                            const bf16x8 af = *(const LAS bf16x8*)(lds + XC + (16 * mt + fr) * TR + (32 * kk + 8 * fq) * 2);
                            acc[mt][0] = __builtin_amdgcn_mfma_f32_16x16x32_bf16(af, Bf[u][kk], acc[mt][0], 0, 0, 0);
                            acc[mt][1] = __builtin_amdgcn_mfma_f32_16x16x32_bf16(af, Bf[2 + u][kk], acc[mt][1], 0, 0, 0);
                        }
                    const int ch = chb + 16 * u + fr;
                    const float ba = gb[ch], bx = gb[192 + ch], sp = gb[384 + ch];
#pragma unroll
                    for (int mt = 0; mt < 4; ++mt)
#pragma unroll
                        for (int j = 0; j < 4; ++j) {
                            const int t = 16 * mt + 4 * fq + j;
                            const float ea = 1.f + __expf(fminf(-(acc[mt][0][j] + ba), 40.f)), ex = 1.f + __expf(fminf(-(acc[mt][1][j] + bx), 40.f));
                            const float inv = __builtin_amdgcn_rcpf(ea * ex);
                            const float r = inv * ex, ig = inv * ea;
                            const float av = __expf(r * sp), om = 1.f - av;
                            const float xcv = __uint_as_float((unsigned)*(const LAS bf16_t*)(lds + XC + t * TR + ch * 2) << 16);
                            const float bt = __builtin_amdgcn_sqrtf(fmaxf(om * (1.f + av), 0.f)) * (ig * xcv);
                            *(LAS bf16_t*)(lds + LAo + t * TR + ch * 2) = (bf16_t)(pk2(om, 0.f) & 0xffffu);
                            *(LAS bf16_t*)(lds + BTo + t * TR + ch * 2) = (bf16_t)(pk2(bt, 0.f) & 0xffffu);
                        }
                    __builtin_amdgcn_sched_barrier(0);
                }
            }
            __syncthreads();
            if (tid < 192) {
#pragma unroll 8
                for (int r = 0; r < 64; ++r) {
                    const float om = __uint_as_float((unsigned)*(const LAS bf16_t*)(lds + LAo + r * TR + tid * 2) << 16);
                    const float bt = __uint_as_float((unsigned)*(const LAS bf16_t*)(lds + BTo + r * TR + tid * 2) << 16);
                    const float g = __uint_as_float((unsigned)*(const LAS bf16_t*)(lds + GT + r * TR + tid * 2) << 16);
                    hst = (hst - om * hst) + bt;
                    *(LAS bf16_t*)(lds + GT + r * TR + tid * 2) = (bf16_t)(pk2(hst * g, 0.f) & 0xffffu);
                }
            } else if (tid >= 256 && tid < 328) {
                const int i = tid - 256, r = i / 24, cc = i % 24;
                const u32x4 v = *(const LAS u32x4*)(lds + XR + (64 + r) * TR + cc * 16);
                *(LAS u32x4*)(lds + XR + r * TR + cc * 16) = v;
            }
            __syncthreads();
            const size_t ob = base + (size_t)tile * 64 * 1536;
#pragma unroll
            for (int j = 0; j < 3; ++j) *(u32x4*)(Y + ob + goff[j]) = *(const LAS u32x4*)(lds + GT + loff[j]);
        }
        __syncthreads();
    }
}


#define XB_TMO      128
#define XB_XCNT(j)  (256  + 64 * (j))
#define XB_XSUB(j)  (1280 + 64 * (j))
#define XB_XGEN(j)  (2304 + 64 * (j))
#define XB_TOP      3328
#define XB_TOPGEN   3392
#define XCD_BAR_WORDS 3456
#define XB_SPIN_CAP (1u << 18)
DI unsigned xb_ld(unsigned* p)              { return __hip_atomic_load(p, __ATOMIC_RELAXED, __HIP_MEMORY_SCOPE_AGENT); }
DI unsigned xb_add(unsigned* p, unsigned v) { return __hip_atomic_fetch_add(p, v, __ATOMIC_RELAXED, __HIP_MEMORY_SCOPE_AGENT); }
DI unsigned xb_xcc_id() { return (unsigned)__builtin_amdgcn_s_getreg((3 << 11) | 20) & 0xFu; }
#define XB_SPIN(cond, bar) do { unsigned _sp = 0; while (cond) { __builtin_amdgcn_s_sleep(1); \
    if ((++_sp & 255u) == 0u) { if (xb_ld(&(bar)[XB_TMO])) break; if (_sp > XB_SPIN_CAP) { atomicAdd(&(bar)[XB_TMO], 1u); break; } } } } while (0)
struct XcdBarrier { unsigned* bar; unsigned x; volatile LAS unsigned* st; };
DI XcdBarrier xcd_barrier_post(unsigned* bar, volatile LAS unsigned* st) {
    XcdBarrier b; b.bar = bar; b.x = xb_xcc_id(); b.st = st;
    if (threadIdx.x == 0) (void)xb_add(&bar[XB_XCNT(b.x)], 1u);
    return b;
}
DI void xcd_barrier_complete(unsigned* bar, unsigned x, unsigned& nloc, unsigned& nx) {
    const unsigned G = gridDim.x * gridDim.y * gridDim.z;
    unsigned sum, cnt, mine, sp = 0u;
    for (;;) {
        sum = 0u; cnt = 0u; mine = 0u;
#pragma unroll
        for (unsigned j = 0; j < 16; ++j) { const unsigned c = xb_ld(&bar[XB_XCNT(j)]); sum += c; cnt += (c > 0u) ? 1u : 0u; mine = (j == x) ? c : mine; }
        if (sum == G) break;
        __builtin_amdgcn_s_sleep(1);
        if ((++sp & 255u) == 0u) { if (xb_ld(&bar[XB_TMO])) break; if (sp > XB_SPIN_CAP) { atomicAdd(&bar[XB_TMO], 1u); break; } }
    }
    nloc = mine > 0u ? mine : 1u; nx = cnt > 0u ? cnt : 1u;
}
DI void xcd_barrier(const XcdBarrier& b) {
    asm volatile("s_waitcnt vmcnt(0)" ::: "memory");
    __syncthreads();
    if (threadIdx.x == 0) {
        unsigned* bar = b.bar;
        __builtin_amdgcn_s_waitcnt(0);
        unsigned nloc = b.st[0], nx = b.st[1];
        if (nloc == 0u) { xcd_barrier_complete(bar, b.x, nloc, nx); b.st[0] = nloc; b.st[1] = nx; }
        const unsigned old = xb_add(&bar[XB_XSUB(b.x)], 1u);
        const unsigned gen = old / nloc;
        if (old + 1u == (gen + 1u) * nloc) {
            __builtin_amdgcn_fence(__ATOMIC_RELEASE, "agent");
            asm volatile("s_waitcnt vmcnt(0)" ::: "memory");
            const unsigned og = xb_add(&bar[XB_TOP], 1u);
            const unsigned tg = og / nx;
            if (og + 1u == (tg + 1u) * nx) xb_add(&bar[XB_TOPGEN], 1u);
            else XB_SPIN(xb_ld(&bar[XB_TOPGEN]) == tg, bar);
            __builtin_amdgcn_fence(__ATOMIC_ACQUIRE, "agent");
            xb_add(&bar[XB_XGEN(b.x)], 1u);
            asm volatile("s_waitcnt vmcnt(0)" ::: "memory");
        } else {
            XB_SPIN(xb_ld(&bar[XB_XGEN(b.x)]) == gen, bar);
            __builtin_amdgcn_fence(__ATOMIC_ACQUIRE, "agent");
            asm volatile("s_waitcnt vmcnt(0)" ::: "memory");
        }
    }
    __syncthreads();
}

__global__ void __launch_bounds__(512) hybrid_fwd(Params p) {
    extern __shared__ __attribute__((aligned(16))) unsigned char shm[];
    LAS unsigned char* lds = (LAS unsigned char*)shm;
    cg::grid_group grid = cg::this_grid();
    volatile LAS unsigned* xst = (volatile LAS unsigned*)(lds + 140272);
    if (threadIdx.x == 0) { xst[0] = 0u; xst[1] = 0u; }
    __syncthreads();
    if (blockIdx.x == 0) { unsigned* bw = (unsigned*)(p.ws + WS_BAR); for (int i = threadIdx.x; i < XCD_BAR_WORDS; i += 512) bw[i] = 0u; }
    grid.sync();
    XcdBarrier xb = xcd_barrier_post((unsigned*)(p.ws + WS_BAR), xst);
    unsigned char* ws = p.ws;
    bf16_t* U = (bf16_t*)(ws + WS_U); bf16_t* RA = (bf16_t*)(ws + WS_RA); bf16_t* RB = (bf16_t*)(ws + WS_RB); bf16_t* RC = (bf16_t*)(ws + WS_RC);
    bf16_t* OUTB = (bf16_t*)p.out;

    PH_BEGIN(0)
    phase_prep(p, shm);
    PH_END
    PH_BEGIN(1)
    { const char* A = (const char*)U; const char* B = (const char*)(ws + WS_WT_XM);
      gemm_phase<true>(lds, 256, 8, 1024, 1024, 1024,
          [=](int pm, int pn, const char*& a, const char*& b) { a = A + (size_t)pm * 256 * 1024 * 2; b = B + (size_t)pn * 256 * 1024 * 2; },
          [=](const f32x4 (&acc)[2][2][4][2], int pm, int pn, int wr, int wc, int fr, int fq) { epi_bf16<0>(acc, RA + (size_t)pm * 256 * 2048 + pn * 256, 2048, wr, wc, fr, fq); }); }
    PH_END
    PH_BEGIN(2)
    if (blockIdx.x < 16) gate_scan(p);
    conv0_phase(RA, p.in[4], p.in[5], RB);
    PH_END
    PH_BEGIN(3)
    { const char* XC = (const char*)RB; const char* XM = (const char*)RA; const char* WQK = (const char*)(ws + WS_WT_QK); const char* WV = (const char*)(ws + WS_WT_V);
      gemm_phase<true>(lds, 256, 16, 512, 2048, 512,
          [=](int pm, int pn, const char*& a, const char*& b) {
              if (pn < 8) { a = XC + ((size_t)pm * 256 * 2048 + (pn >> 1) * 512) * 2; b = WQK + (size_t)pn * 256 * 512 * 2; }
              else { a = XM + ((size_t)pm * 256 * 2048 + ((pn - 8) >> 1) * 512) * 2; b = WV + (size_t)(pn - 8) * 256 * 512 * 2; } },
          [=](const f32x4 (&acc)[2][2][4][2], int pm, int pn, int wr, int wc, int fr, int fq) {
              if (pn < 8) epi_bf16<0>(acc, OUTB + (size_t)(pn & 1) * T_ * 1024 + (size_t)pm * 256 * 1024 + (pn >> 1) * 256, 1024, wr, wc, fr, fq);
              else epi_bf16<0>(acc, RC + (size_t)pm * 256 * 2048 + (pn - 8) * 256, 2048, wr, wc, fr, fq); }); }
    PH_END
    PH_BEGIN(4)
    phase_mlstm(p, shm);
    PH_END
    PH_BEGIN(5)
    { const char* A = (const char*)U; const char* B = (const char*)(ws + WS_WT_ZO);
      gemm_phase<true>(lds, 256, 16, 1024, 1024, 1024,
          [=](int pm, int pn, const char*& a, const char*& b) { a = A + (size_t)pm * 256 * 1024 * 2; b = B + (size_t)pn * 256 * 1024 * 2; },
          [=](const f32x4 (&acc)[2][2][4][2], int pm, int pn, int wr, int wc, int fr, int fq) {
              const int esz = pn < 8 ? 2 : 1;
              unsigned char* Ob = (pn < 8 ? (unsigned char*)RC : (unsigned char*)OUTB) + ((size_t)pm * 256 * 2048 + (pn & 7) * 256) * esz;
              epi_zo(acc, Ob, esz, wr, wc, fr, fq); }); }
    PH_END
    PH_BEGIN(6)
    phase_post(p);
    PH_END
    PH_BEGIN(7)
    { const char* A = (const char*)RA; const char* B = (const char*)(ws + WS_WT_OUT0); const float* X = p.in[0]; float* X1 = p.out; float* SS1 = (float*)(ws + WS_SS1);
      gemm_phase<false>(lds, 256, 4, 2048, 2048, 2048,
          [=](int pm, int pn, const char*& a, const char*& b) { a = A + (size_t)pm * 256 * 2048 * 2; b = B + (size_t)pn * 256 * 2048 * 2; },
          [=](const f32x4 (&acc)[2][2][4][2], int pm, int pn, int wr, int wc, int fr, int fq) {
#pragma unroll
              for (int ai = 0; ai < 2; ++ai)
#pragma unroll
                  for (int m = 0; m < 4; ++m) { const int row = pm * 256 + ai * 128 + wr * 64 + m * 16 + fr; const size_t ro = (size_t)row * 1024 + pn * 256 + wc * 32 + 4 * fq;
                      float ssq = 0.f;
#pragma unroll
                      for (int bj = 0; bj < 2; ++bj)
#pragma unroll
                          for (int n = 0; n < 2; ++n) { const size_t o = ro + bj * 128 + n * 16; const f32x4 v = *(const f32x4*)(X + o) + acc[ai][bj][m][n];
                              u32x2 wv; wv[0] = pk2(v[0], v[1]); wv[1] = pk2(v[2], v[3]); *(u32x2*)(U + o) = wv;
                              ssq += v[0] * v[0] + v[1] * v[1] + v[2] * v[2] + v[3] * v[3]; }
                      ssq += __shfl_xor(ssq, 16); ssq += __shfl_xor(ssq, 32);
                      if (fq == 0) unsafeAtomicAdd(SS1 + row, ssq); } }); }
    PH_END
    PH_BEGIN(9)
    { const char* A = (const char*)U; const char* B = (const char*)(ws + WS_WT_IN1);
      gemm_phase<true>(lds, 256, 12, 1024, 1024, 1024,
          [=](int pm, int pn, const char*& a, const char*& b) { a = A + (size_t)pm * 256 * 1024 * 2; b = B + (size_t)pn * 256 * 1024 * 2; },
          [=](const f32x4 (&acc)[2][2][4][2], int pm, int pn, int wr, int wc, int fr, int fq) {
              const float* ssr = (const float*)(ws + WS_SS1) + pm * 256;
              if (pn < 6) epi_bf16<0>(acc, RA + (size_t)pm * 256 * 1536 + pn * 256, 1536, wr, wc, fr, fq, ssr);
              else epi_bf16<1>(acc, RC + (size_t)pm * 256 * 1536 + (pn - 6) * 256, 1536, wr, wc, fr, fq, ssr); }); }
    PH_END
    PH_BEGIN(10)
    phase_rglru(p, shm);
    PH_END
    { const char* A = (const char*)RB; const char* B = (const char*)(ws + WS_WT_OUT1); bf16_t* X2B = RA; const f32x4* fg = (const f32x4*)p.in[2]; f32x4* O4 = (f32x4*)p.out;
      LAS float* rowss = (LAS float*)(lds + 131072);
      for (int panel = blockIdx.x; panel < 256; panel += gridDim.x) {
          { const int tid = opq(threadIdx.x); if (tid < 256) rowss[tid] = 0.f; }
          __syncthreads();
          gemm_phase<false>(lds, 256, 4, 1536, 1536, 1536,
              [=](int pm, int pn, const char*& a, const char*& b) { a = A + (size_t)pm * 256 * 1536 * 2; b = B + (size_t)pn * 256 * 1536 * 2; },
              [=](const f32x4 (&acc)[2][2][4][2], int pm, int pn, int wr, int wc, int fr, int fq) {
#pragma unroll
                  for (int ai = 0; ai < 2; ++ai)
#pragma unroll
                      for (int m = 0; m < 4; ++m) { const int rl = ai * 128 + wr * 64 + m * 16 + fr; const size_t ro = (size_t)(pm * 256 + rl) * 1024 + pn * 256 + wc * 32 + 4 * fq;
                          float ssq = 0.f;
#pragma unroll
                          for (int bj = 0; bj < 2; ++bj)
#pragma unroll
                              for (int n = 0; n < 2; ++n) { const size_t o = ro + bj * 128 + n * 16; const u32x2 xb = *(const u32x2*)(U + o);
                                  const f32x4 v = (f32x4){bflo(xb[0]), bfhi(xb[0]), bflo(xb[1]), bfhi(xb[1])} + acc[ai][bj][m][n];
                                  u32x2 wv; wv[0] = pk2(v[0], v[1]); wv[1] = pk2(v[2], v[3]); *(u32x2*)(X2B + o) = wv;
                                  ssq += v[0] * v[0] + v[1] * v[1] + v[2] * v[2] + v[3] * v[3]; }
                          ssq += __shfl_xor(ssq, 16); ssq += __shfl_xor(ssq, 32);
                          if (fq == 0) __hip_atomic_fetch_add((float*)(shm + 131072) + rl, ssq, __ATOMIC_RELAXED, __HIP_MEMORY_SCOPE_WORKGROUP); } }, panel);
          asm volatile("s_waitcnt vmcnt(0)" ::: "memory");
          __syncthreads();
          { const int tid = opq(threadIdx.x);
            for (int idx = tid; idx < 256 * 128; idx += 512) {
                const int row = idx >> 7, c = idx & 127; const size_t go = (size_t)(panel * 256 + row);
                const u32x4 xb = *(const u32x4*)(X2B + go * 1024 + c * 8);
                const float r = __builtin_amdgcn_rsqf(rowss[row] * (1.f / 1024.f) + EPS_);
                float f[8]; unpack8(xb, f);
                const f32x4 g0 = fg[2 * c], g1 = fg[2 * c + 1];
                O4[go * 256 + 2 * c] = (f32x4){f[0], f[1], f[2], f[3]} * r * g0;
                O4[go * 256 + 2 * c + 1] = (f32x4){f[4], f[5], f[6], f[7]} * r * g1; } }
          __syncthreads();
      } }
}

extern "C" void kernel_launch(void* const* d_in, const int* in_sizes, int n_in, void* d_out, int out_size, void* d_ws, size_t ws_size, hipStream_t stream) {
    static int grid_blocks = 0;
    if (!grid_blocks) {
        int dev = 0, cus = 0, per_cu = 0;
        hipGetDevice(&dev);
        hipDeviceGetAttribute(&cus, hipDeviceAttributeMultiprocessorCount, dev);
        hipFuncSetAttribute((const void*)hybrid_fwd, hipFuncAttributeMaxDynamicSharedMemorySize, LDS_BYTES);
        hipOccupancyMaxActiveBlocksPerMultiprocessor(&per_cu, (const void*)hybrid_fwd, 512, LDS_BYTES);
        if (per_cu < 1) { fprintf(stderr, "occupancy query returned %d\n", per_cu); per_cu = 1; }
        grid_blocks = cus * per_cu;
        if (grid_blocks > 256) grid_blocks = 256;
    }
    Params p{};
    for (int i = 0; i < 23; ++i) p.in[i] = (const float*)d_in[i];
    p.out = (float*)d_out; p.ws = (unsigned char*)d_ws; p.rep_mask = REP_MASK;
    void* args[] = {&p};
    hipError_t e = hipLaunchCooperativeKernel((const void*)hybrid_fwd, dim3(grid_blocks), dim3(512), args, LDS_BYTES, stream);
    if (e != hipSuccess) fprintf(stderr, "cooperative launch failed: %s (grid %d)\n", hipGetErrorString(e), grid_blocks);
}
```

```cpp
#include <hip/hip_runtime.h>
#include <hip/hip_cooperative_groups.h>
#include <cstdio>
namespace cg = cooperative_groups;

#define DI __device__ __forceinline__
#define LAS __attribute__((address_space(3)))
typedef unsigned short bf16_t;
typedef short bf16x8 __attribute__((ext_vector_type(8)));
typedef short s16x4 __attribute__((ext_vector_type(4)));
typedef float f32x2 __attribute__((ext_vector_type(2)));
typedef float f32x4 __attribute__((ext_vector_type(4)));
typedef float f32x16 __attribute__((ext_vector_type(16)));
typedef unsigned u32x2 __attribute__((ext_vector_type(2)));
typedef unsigned u32x4 __attribute__((ext_vector_type(4)));
typedef __bf16 bf2_t __attribute__((ext_vector_type(2)));

constexpr int T_ = 65536, S_ = 2048;
constexpr float EPS_ = 1e-6f;
constexpr size_t MB_ = 1u << 20;
constexpr size_t WS_WT_XM = 0, WS_WT_ZO = 4 * MB_, WS_WT_QK = 12 * MB_, WS_WT_V = 14 * MB_, WS_WT_OUT0 = 16 * MB_, WS_WT_IN1 = 20 * MB_,
                 WS_WT_G = 26 * MB_, WS_WT_OUT1 = 28 * MB_, WS_LI = 31 * MB_, WS_LF = 32 * MB_, WS_GP = 33 * MB_, WS_GQ = 34 * MB_, WS_GD = 35 * MB_,
                 WS_GF = 36 * MB_, WS_GW = 37 * MB_, WS_SS = 38 * MB_, WS_U = 40 * MB_, WS_RA = 168 * MB_, WS_RB = 424 * MB_, WS_RC = 680 * MB_,
                 WS_LA = 40 * MB_, WS_BT = 232 * MB_, WS_SP = 39 * MB_, WS_SS1 = 38 * MB_ + 512 * 1024, WS_BAR = 39 * MB_ + 65536;
constexpr int LDS_BYTES = 140288;

struct Params { const float* in[23]; float* out; unsigned char* ws; unsigned rep_mask; unsigned pad; };
#ifndef REP_MASK
#define REP_MASK 0u
#endif
#ifndef PH_MASK
#define PH_MASK 0xffffu
#endif
#define PH_BEGIN(k) for (int r_ = 0, n_ = ((PH_MASK >> (k)) & 1u) ? 1 + (int)((p.rep_mask >> (k)) & 1u) : 0; r_ < n_; ++r_) {
#define PH_END xcd_barrier(xb); }
#define PH_END_CG grid.sync(); }

DI unsigned pk2(float a, float b) { f32x2 v = {a, b}; bf2_t r = __builtin_convertvector(v, bf2_t); return __builtin_bit_cast(unsigned, r); }
DI int opq(int x) { asm volatile("" : "+v"(x)); return x; }
DI float bflo(unsigned u) { return __uint_as_float(u << 16); }
DI float bfhi(unsigned u) { return __uint_as_float(u & 0xffff0000u); }
DI float sigm(float x) { return __builtin_amdgcn_rcpf(1.f + __expf(-x)); }
DI float silu_(float x) { return x * __builtin_amdgcn_rcpf(1.f + __expf(-x)); }
DI float wave_sum(float v) {
    v += __int_as_float(__builtin_amdgcn_update_dpp(0, __float_as_int(v), 0xB1, 0xf, 0xf, true));
    v += __int_as_float(__builtin_amdgcn_update_dpp(0, __float_as_int(v), 0x4E, 0xf, 0xf, true));
    v += __int_as_float(__builtin_amdgcn_update_dpp(0, __float_as_int(v), 0x141, 0xf, 0xf, true));
    v += __int_as_float(__builtin_amdgcn_update_dpp(0, __float_as_int(v), 0x140, 0xf, 0xf, true));
    const int vi = __float_as_int(v);
    return (__int_as_float(__builtin_amdgcn_readlane(vi, 0)) + __int_as_float(__builtin_amdgcn_readlane(vi, 16))) +
           (__int_as_float(__builtin_amdgcn_readlane(vi, 32)) + __int_as_float(__builtin_amdgcn_readlane(vi, 48)));
}
DI void unpack8(const u32x4& u, float (&f)[8]) {
#pragma unroll
    for (int i = 0; i < 4; ++i) { f[2 * i] = bflo(u[i]); f[2 * i + 1] = bfhi(u[i]); }
}
DI unsigned pk_fp8x4(float a, float b, float c, float d) { int w = __builtin_amdgcn_cvt_pk_fp8_f32(a, b, 0, false); w = __builtin_amdgcn_cvt_pk_fp8_f32(c, d, w, true); return (unsigned)w; }
DI void unpack_fp8x8(const u32x2& u, float (&f)[8]) {
    f[0] = __builtin_amdgcn_cvt_f32_fp8((int)u[0], 0); f[1] = __builtin_amdgcn_cvt_f32_fp8((int)u[0], 1); f[2] = __builtin_amdgcn_cvt_f32_fp8((int)u[0], 2); f[3] = __builtin_amdgcn_cvt_f32_fp8((int)u[0], 3);
    f[4] = __builtin_amdgcn_cvt_f32_fp8((int)u[1], 0); f[5] = __builtin_amdgcn_cvt_f32_fp8((int)u[1], 1); f[6] = __builtin_amdgcn_cvt_f32_fp8((int)u[1], 2); f[7] = __builtin_amdgcn_cvt_f32_fp8((int)u[1], 3);
}
DI u32x4 pack8f(const float (&f)[8]) { u32x4 r; r[0] = pk2(f[0], f[1]); r[1] = pk2(f[2], f[3]); r[2] = pk2(f[4], f[5]); r[3] = pk2(f[6], f[7]); return r; }

constexpr int BM = 256, BK = 64, HALF = 128, HTB = HALF * BK * 2, NXCD = 8, WGM = 8;
DI int lds_byte(int r, int c) { const int st = (r >> 4) * 2 + (c >> 5), rr = r & 15, cc = c & 31, ob = rr * 64 + cc * 2; return st * 1024 + (ob ^ (((ob >> 9) & 1) << 5)); }
DI void stage_rc(int b, int& R, int& C) { const int st = b / 1024, sb = b % 1024, swz = sb ^ (((sb >> 9) & 1) << 5); R = (st >> 1) * 16 + swz / 64; C = (st & 1) * 32 + (swz % 64) / 2; }
DI int perm32(int rho) { const int n = rho >> 4, i = rho & 15; return 8 * (i >> 2) + 4 * n + (i & 3); }

DI bool unit_next(int i, int nM, int nN, int vb, int& pm, int& pn) {
    const int nwg = nM * nN; const long L = (long)i * gridDim.x + vb; if (L >= nwg) return false;
    int wgid = (int)L; { const int q = nwg / NXCD, r = nwg % NXCD, xcd = wgid % NXCD, off = wgid / NXCD; wgid = (xcd < r ? xcd * (q + 1) : r * (q + 1) + (xcd - r) * q) + off; }
    const int nig = WGM * nN, gid = wgid / nig, fm = gid * WGM, gsz = (nM - fm) < WGM ? (nM - fm) : WGM;
    pm = fm + ((wgid % nig) % gsz); pn = (wgid % nig) / gsz; return true;
}

template <bool PERM, class Dec, class Epi>
DI void gemm_phase(LAS unsigned char* lds, const int nM, const int nN, const int K, const int lda, const int ldb, const Dec& dec, const Epi& epi, const int vb, const int panel = -1) {
    const int tid = opq(threadIdx.x), wid = __builtin_amdgcn_readfirstlane(tid >> 6), lane = tid & 63, wr = wid >> 2, wc = wid & 3, fr = lane & 15, fq = lane >> 4;
    const int nt = K / BK;
    unsigned voffA[2], voffB[2];
#pragma unroll
    for (int i = 0; i < 2; ++i) { int R, C; stage_rc(tid * 16 + i * 8192, R, C); const int Rb = PERM ? ((R & ~31) + perm32(R & 31)) : R;
        voffA[i] = (unsigned)(R * lda + C) * 2u; voffB[i] = (unsigned)(Rb * ldb + C) * 2u; }
    const size_t kstep = (size_t)(BK * 2);
    const size_t hstepA = (size_t)HALF * lda * 2, hstepB = (size_t)HALF * ldb * 2;
    const unsigned ldsw = (unsigned)wid * 1024u;
    const int aoff = lds_byte(wr * 64 + fr, fq * 8), boff = lds_byte(wc * 32 + fr, fq * 8);
#define G_SA(b, h) (((b) * 2 + (h)) * HTB)
#define G_SB(b, h) ((4 + (b) * 2 + (h)) * HTB)
#define G_STAGE(bufoff, gbase, voff) do { _Pragma("unroll") for (int _i = 0; _i < 2; ++_i) \
        __builtin_amdgcn_global_load_lds((const unsigned*)((const char*)(gbase) + (voff)[_i]), (LAS unsigned*)(lds + (bufoff) + ldsw + _i * 8192), 16, 0, 0); } while (0)
#define G_LDA(dst, b, h) do { _Pragma("unroll") for (int m = 0; m < 4; ++m) _Pragma("unroll") for (int k = 0; k < 2; ++k) dst[m][k] = *(const LAS bf16x8*)(lds + G_SA(b, h) + aoff + m * 2048 + k * 1024); } while (0)
#define G_LDB(dst, b, h) do { _Pragma("unroll") for (int n = 0; n < 2; ++n) _Pragma("unroll") for (int k = 0; k < 2; ++k) dst[n][k] = *(const LAS bf16x8*)(lds + G_SB(b, h) + boff + n * 2048 + k * 1024); } while (0)
#define G_MMA(ai, bj, At, Bt) do { __builtin_amdgcn_s_setprio(1); _Pragma("unroll") for (int m = 0; m < 4; ++m) _Pragma("unroll") for (int n = 0; n < 2; ++n) _Pragma("unroll") for (int k = 0; k < 2; ++k) \
        acc[ai][bj][m][n] = __builtin_amdgcn_mfma_f32_16x16x32_bf16(Bt[n][k], At[m][k], acc[ai][bj][m][n], 0, 0, 0); __builtin_amdgcn_s_setprio(0); } while (0)
#define G_WAIT_V(n) asm volatile("s_waitcnt vmcnt(" #n ")" ::: "memory")
#define G_WAIT_L(n) asm volatile("s_waitcnt lgkmcnt(" #n ")" ::: "memory")
#define G_BAR __builtin_amdgcn_s_barrier()
#define G_SCHED __builtin_amdgcn_sched_barrier(0)
    int cpm, cpn, npm, npn, ui = 0;
    if (panel >= 0) { cpm = panel; cpn = 0; } else if (!unit_next(0, nM, nN, vb, cpm, cpn)) return;
    f32x4 acc[2][2][4][2];
#pragma unroll
    for (int a = 0; a < 2; ++a)
#pragma unroll
        for (int b = 0; b < 2; ++b)
#pragma unroll
            for (int m = 0; m < 4; ++m)
#pragma unroll
                for (int n = 0; n < 2; ++n) acc[a][b][m][n] = (f32x4){0.f, 0.f, 0.f, 0.f};
    bf16x8 At[4][2], B0[2][2], B1[2][2];
    const char* cA; const char* cB; dec(cpm, cpn, cA, cB);
    G_STAGE(G_SB(0, 0), cB, voffB); G_STAGE(G_SA(0, 0), cA, voffA); G_STAGE(G_SB(0, 1), cB + hstepB, voffB); G_STAGE(G_SA(0, 1), cA + hstepA, voffA);
    if (wr == 1) G_BAR;
    G_WAIT_V(4); G_BAR;
    G_STAGE(G_SB(1, 0), cB + kstep, voffB); G_STAGE(G_SA(1, 0), cA + kstep, voffA); G_STAGE(G_SB(1, 1), cB + hstepB + kstep, voffB);
    G_WAIT_V(6); G_BAR;
    for (;;) {
        bool has_next;
        if (panel >= 0) { has_next = (ui + 1 < nN); npm = panel; npn = ui + 1; } else has_next = unit_next(ui + 1, nM, nN, vb, npm, npn);
        const char* nA = cA; const char* nB = cB; if (has_next) dec(npm, npn, nA, nB);
#pragma nounroll
        for (int t = 0; t < nt; t += 2) {
            const bool last = (t == nt - 2);
            const char* a1 = cA + (size_t)(t + 1) * kstep;
            const char* a2 = last ? nA : cA + (size_t)(t + 2) * kstep; const char* b2 = last ? nB : cB + (size_t)(t + 2) * kstep;
            const char* a3 = a2 + kstep; const char* b3 = b2 + kstep;
            G_LDB(B0, 0, 0); G_SCHED; G_LDA(At, 0, 0); G_STAGE(G_SA(1, 1), a1 + hstepA, voffA);
            G_WAIT_L(8); G_BAR; G_WAIT_L(0); G_MMA(0, 0, At, B0); G_BAR; G_SCHED;
            G_LDB(B1, 0, 1); G_STAGE(G_SB(0, 0), b2, voffB);
            G_BAR; G_WAIT_L(0); G_MMA(0, 1, At, B1); G_BAR;
            G_LDA(At, 0, 1); G_STAGE(G_SA(0, 0), a2, voffA);
            G_BAR; G_WAIT_L(0); G_MMA(1, 0, At, B0); G_BAR; G_SCHED;
            G_STAGE(G_SB(0, 1), b2 + hstepB, voffB);
            G_WAIT_V(6); G_BAR; G_MMA(1, 1, At, B1); G_BAR;
            G_LDB(B0, 1, 0); G_SCHED; G_LDA(At, 1, 0); G_STAGE(G_SA(0, 1), a2 + hstepA, voffA);
            G_WAIT_L(8); G_BAR; G_WAIT_L(0); G_MMA(0, 0, At, B0); G_BAR; G_SCHED;
            G_LDB(B1, 1, 1); G_STAGE(G_SB(1, 0), b3, voffB);
            G_BAR; G_WAIT_L(0); G_MMA(0, 1, At, B1); G_BAR;
            G_LDA(At, 1, 1); G_STAGE(G_SA(1, 0), a3, voffA);
            G_BAR; G_WAIT_L(0); G_MMA(1, 0, At, B0); G_BAR; G_SCHED;
            G_STAGE(G_SB(1, 1), b3 + hstepB, voffB);
            G_WAIT_V(6); G_BAR; G_MMA(1, 1, At, B1); G_BAR;
        }
        epi(acc, cpm, cpn, wr, wc, fr, fq);
        if (!has_next) break;
#pragma unroll
        for (int a = 0; a < 2; ++a)
#pragma unroll
            for (int b = 0; b < 2; ++b)
#pragma unroll
                for (int m = 0; m < 4; ++m)
#pragma unroll
                    for (int n = 0; n < 2; ++n) acc[a][b][m][n] = (f32x4){0.f, 0.f, 0.f, 0.f};
        cpm = npm; cpn = npn; cA = nA; cB = nB; ++ui;
    }
    G_WAIT_V(0);
    if (wr == 0) G_BAR;
    G_BAR;
#undef G_SA
#undef G_SB
#undef G_STAGE
#undef G_LDA
#undef G_LDB
#undef G_MMA
#undef G_WAIT_V
#undef G_WAIT_L
#undef G_BAR
#undef G_SCHED
}

template <int ACT>
DI void epi_bf16(const f32x4 (&acc)[2][2][4][2], bf16_t* O, const int ldc, int wr, int wc, int fr, int fq, const float* ssrow = nullptr) {
#pragma unroll
    for (int ai = 0; ai < 2; ++ai)
#pragma unroll
        for (int m = 0; m < 4; ++m) {
            bf16_t* rowp = O + (size_t)(ai * HALF + wr * 64 + m * 16 + fr) * ldc + wc * 32 + 8 * fq;
            const float rsc = ssrow ? __builtin_amdgcn_rsqf(ssrow[ai * HALF + wr * 64 + m * 16 + fr] * (1.f / 1024.f) + EPS_) : 1.f;
#pragma unroll
            for (int bj = 0; bj < 2; ++bj) {
                f32x4 v0 = acc[ai][bj][m][0] * rsc, v1 = acc[ai][bj][m][1] * rsc;
                if (ACT == 1) {
#pragma unroll
                    for (int j = 0; j < 4; ++j) { v0[j] = silu_(v0[j]); v1[j] = silu_(v1[j]); } }
                if (ACT == 2) {
#pragma unroll
                    for (int j = 0; j < 4; ++j) { v0[j] = sigm(v0[j]); v1[j] = sigm(v1[j]); } }
                u32x4 w; w[0] = pk2(v0[0], v0[1]); w[1] = pk2(v0[2], v0[3]); w[2] = pk2(v1[0], v1[1]); w[3] = pk2(v1[2], v1[3]);
                *(u32x4*)(rowp + bj * HALF) = w;
            }
        }
}

DI void epi_zo(const f32x4 (&acc)[2][2][4][2], unsigned char* O, const int esz, int wr, int wc, int fr, int fq) {
#pragma unroll
    for (int ai = 0; ai < 2; ++ai)
#pragma unroll
        for (int m = 0; m < 4; ++m) {
            unsigned char* rowp = O + ((size_t)(ai * HALF + wr * 64 + m * 16 + fr) * 2048 + wc * 32 + 8 * fq) * esz;
#pragma unroll
            for (int bj = 0; bj < 2; ++bj) {
                const f32x4 v0 = acc[ai][bj][m][0], v1 = acc[ai][bj][m][1];
                if (esz == 2) { u32x4 w; w[0] = pk2(v0[0], v0[1]); w[1] = pk2(v0[2], v0[3]); w[2] = pk2(v1[0], v1[1]); w[3] = pk2(v1[2], v1[3]); *(u32x4*)(rowp + bj * HALF * 2) = w; }
                else { u32x2 w; w[0] = pk_fp8x4(v0[0], v0[1], v0[2], v0[3]); w[1] = pk_fp8x4(v1[0], v1[1], v1[2], v1[3]); *(u32x2*)(rowp + bj * HALF) = w; }
            }
        }
}

struct TJob { const float* src; bf16_t* dst; int lds_, srcb, K, N, ldd, dstb; float scale; const float* ks; };
DI TJob get_job(const Params& p, int j) {
    TJob t; unsigned char* ws = p.ws;
    switch (j) {
    case 0: t = TJob{p.in[3], (bf16_t*)(ws + WS_WT_XM), 6152, 0, 1024, 2048, 1024, 0, 1.f, nullptr}; break;
    case 1: t = TJob{p.in[3] + 2048, (bf16_t*)(ws + WS_WT_ZO), 6152, 0, 1024, 4096, 1024, 0, 1.f, nullptr}; break;
    case 2: t = TJob{p.in[6], (bf16_t*)(ws + WS_WT_QK), 256, 512 * 256, 512, 256, 512, 512 * 512, 0.0625f, nullptr}; break;
    case 3: t = TJob{p.in[7], (bf16_t*)(ws + WS_WT_QK) + 256 * 512, 256, 512 * 256, 512, 256, 512, 512 * 512, 1.f, nullptr}; break;
    case 4: t = TJob{p.in[8], (bf16_t*)(ws + WS_WT_V), 512, 512 * 512, 512, 512, 512, 512 * 512, 1.f, nullptr}; break;
    case 5: t = TJob{p.in[13], (bf16_t*)(ws + WS_WT_OUT0), 1024, 0, 2048, 1024, 2048, 0, 1.f, nullptr}; break;
    case 6: t = TJob{p.in[14], (bf16_t*)(ws + WS_WT_IN1), 3072, 0, 1024, 3072, 1024, 0, 1.f, p.in[1] + 1024}; break;
    default: t = TJob{p.in[22], (bf16_t*)(ws + WS_WT_OUT1), 1024, 0, 1536, 1024, 1536, 0, 1.f, nullptr}; break;
    }
    return t;
}

template <bool GATES>
DI void rmsnorm_rows(const float* X, const float* g, bf16_t* U, const float* Wg, const float* b_i, const float* b_f, float* LI, float* LF) {
    const int tid_ = opq(threadIdx.x), lane = tid_ & 63, wid = tid_ >> 6;
    const int gw = blockIdx.x * 8 + wid, nw = gridDim.x * 8;
    f32x4 g4[4];
#pragma unroll
    for (int i = 0; i < 4; ++i) g4[i] = ((const f32x4*)g)[lane + 64 * i];
    f32x4 nx[4];
#pragma unroll
    for (int i = 0; i < 4; ++i) nx[i] = ((const f32x4*)(X + (size_t)gw * 1024))[lane + 64 * i];
    for (int row = gw; row < T_; row += nw) {
        f32x4 v[4]; float ss = 0.f;
        const int rown = (row + nw < T_) ? row + nw : row;
#pragma unroll
        for (int i = 0; i < 4; ++i) { v[i] = nx[i]; nx[i] = ((const f32x4*)(X + (size_t)rown * 1024))[lane + 64 * i]; ss += v[i][0] * v[i][0] + v[i][1] * v[i][1] + v[i][2] * v[i][2] + v[i][3] * v[i][3]; }
        ss = wave_sum(ss);
        const float rs = __builtin_amdgcn_rsqf(ss * (1.f / 1024.f) + EPS_);
#pragma unroll
        for (int i = 0; i < 4; ++i) { v[i] = v[i] * rs * g4[i]; u32x2 w; w[0] = pk2(v[i][0], v[i][1]); w[1] = pk2(v[i][2], v[i][3]); ((u32x2*)(U + (size_t)row * 1024))[lane + 64 * i] = w; }
        if (GATES) {
            float d[8];
#pragma unroll
            for (int j = 0; j < 8; ++j) { float s = 0.f;
#pragma unroll
                for (int i = 0; i < 4; ++i) { const f32x4 w = ((const f32x4*)(Wg + j * 1024))[lane + 64 * i]; s += v[i][0] * w[0] + v[i][1] * w[1] + v[i][2] * w[2] + v[i][3] * w[3]; }
                d[j] = wave_sum(s); }
            float val = d[0];
#pragma unroll
            for (int j = 1; j < 8; ++j) val = (lane == j) ? d[j] : val;
            if (lane < 8) {
                const int b = row >> 11, s = row & 2047, hh = lane & 3;
                if (lane < 4) LI[(size_t)(b * 4 + hh) * S_ + s] = val + b_i[hh];
                else { const float xx = val + b_f[hh]; LF[(size_t)(b * 4 + hh) * S_ + s] = fminf(xx, 0.f) - log1pf(__expf(-fabsf(xx))); }
            }
        }
    }
}

DI void phase_prep(const Params& p, unsigned char* shm) {
    const int tid = opq(threadIdx.x);
    const size_t gtid = (size_t)blockIdx.x * 512 + tid, gsize = (size_t)gridDim.x * 512;
    float* tl = (float*)shm;
    float* Wg = (float*)(shm + 20480);
    for (int idx = tid; idx < 8192; idx += 512) { const int j = idx >> 10, k = idx & 1023; Wg[idx] = p.in[3][(size_t)k * 6152 + 6144 + j]; }
    for (int tile = blockIdx.x; tile < 3712; tile += gridDim.x) {
        int j, base;
        if (tile < 512) { j = 0; base = 0; } else if (tile < 1536) { j = 1; base = 512; } else if (tile < 1664) { j = 2; base = 1536; } else if (tile < 1792) { j = 3; base = 1664; }
        else if (tile < 2048) { j = 4; base = 1792; } else if (tile < 2560) { j = 5; base = 2048; } else if (tile < 3328) { j = 6; base = 2560; } else { j = 7; base = 3328; }
        const TJob jb = get_job(p, j);
        const int lt = tile - base, ntn = jb.N / 64, ntk = jb.K / 64;
        const int b = lt / (ntn * ntk), r = lt % (ntn * ntk), tk = r / ntn, tn = r % ntn;
        const float* src = jb.src + (size_t)b * jb.srcb + (size_t)(tk * 64) * jb.lds_ + tn * 64;
#pragma unroll
        for (int i = 0; i < 2; ++i) { const int kk = (tid >> 4) + 32 * i, c4 = (tid & 15) * 4; const f32x4 v = *(const f32x4*)(src + (size_t)kk * jb.lds_ + c4);
            const float sc = jb.ks ? jb.scale * jb.ks[tk * 64 + kk] : jb.scale;
            tl[kk * 65 + c4] = v[0] * sc; tl[kk * 65 + c4 + 1] = v[1] * sc; tl[kk * 65 + c4 + 2] = v[2] * sc; tl[kk * 65 + c4 + 3] = v[3] * sc; }
        __syncthreads();
        { const int n = tid >> 3, k8 = (tid & 7) * 8; float f[8];
#pragma unroll
          for (int e = 0; e < 8; ++e) f[e] = tl[(k8 + e) * 65 + n];
          *(u32x4*)(jb.dst + (size_t)b * jb.dstb + (size_t)(tn * 64 + n) * jb.ldd + tk * 64 + k8) = pack8f(f); }
        __syncthreads();
    }
    { bf16_t* WG = (bf16_t*)(p.ws + WS_WT_G);
      for (size_t idx = gtid; idx < (size_t)8 * 2 * 192 * 192; idx += gsize) {
          const int c = (int)(idx % 192), d = (int)((idx / 192) % 192), g = (int)((idx / 36864) & 1), blk = (int)(idx / 73728);
          const float v = (g ? p.in[19] : p.in[17])[(size_t)blk * 36864 + (size_t)c * 192 + d];
          WG[idx] = (bf16_t)(pk2(v, 0.f) & 0xffffu); } }
    { float* SS = (float*)(p.ws + WS_SS); float* SS1 = (float*)(p.ws + WS_SS1); for (size_t idx = gtid; idx < (size_t)T_; idx += gsize) { SS[idx] = 0.f; SS1[idx] = 0.f; } }
    { float* SP = (float*)(p.ws + WS_SP); for (size_t idx = gtid; idx < (size_t)1536; idx += gsize) SP[idx] = -8.f * log1pf(__expf(-p.in[21][idx])); }
    __syncthreads();
    rmsnorm_rows<true>(p.in[0], p.in[1], (bf16_t*)(p.ws + WS_U), Wg, p.in[9], p.in[10], (float*)(p.ws + WS_LI), (float*)(p.ws + WS_LF));
}

template <int CIN, int COUT, bool SILU>
DI void conv_phase(const bf16_t* X, const float* w, const float* bias, bf16_t* Y) {
    constexpr int NG = COUT / 8, NGV = CIN / 8;
    const int total = (T_ / 16) * NG;
    for (int it = blockIdx.x * 512 + opq(threadIdx.x); it < total; it += gridDim.x * 512) {
        const int cgp = it % NG, tc = it / NG, t0 = tc * 16;
        if (cgp >= NGV) {
            for (int r = 0; r < 16; ++r) *(u32x4*)(Y + (size_t)(t0 + r) * COUT + cgp * 8) = (u32x4){0u, 0u, 0u, 0u};
            continue;
        }
        const int c0 = cgp * 8;
        float w0[8], w1[8], w2[8], w3[8], bb[8], p3[8], p2[8], p1[8];
#pragma unroll
        for (int e = 0; e < 8; ++e) { w0[e] = w[c0 + e]; w1[e] = w[CIN + c0 + e]; w2[e] = w[2 * CIN + c0 + e]; w3[e] = w[3 * CIN + c0 + e]; bb[e] = bias[c0 + e]; }
        if ((t0 & 2047) == 0) {
#pragma unroll
            for (int e = 0; e < 8; ++e) { p3[e] = 0.f; p2[e] = 0.f; p1[e] = 0.f; }
        } else {
            unpack8(*(const u32x4*)(X + (size_t)(t0 - 3) * CIN + c0), p3);
            unpack8(*(const u32x4*)(X + (size_t)(t0 - 2) * CIN + c0), p2);
            unpack8(*(const u32x4*)(X + (size_t)(t0 - 1) * CIN + c0), p1);
        }
#pragma unroll
        for (int r = 0; r < 16; ++r) {
            float cur[8], y[8];
            unpack8(*(const u32x4*)(X + (size_t)(t0 + r) * CIN + c0), cur);
#pragma unroll
            for (int e = 0; e < 8; ++e) { float v = bb[e] + w0[e] * p3[e] + w1[e] * p2[e] + w2[e] * p1[e] + w3[e] * cur[e]; y[e] = SILU ? silu_(v) : v; p3[e] = p2[e]; p2[e] = p1[e]; p1[e] = cur[e]; }
            *(u32x4*)(Y + (size_t)(t0 + r) * COUT + c0) = pack8f(y);
        }
    }
}

DI void conv0_phase(const bf16_t* X, const float* w, const float* bias, bf16_t* Y) {
    const int gt = blockIdx.x * 512 + opq(threadIdx.x), stride = gridDim.x * 512;
    const int c0 = (gt & 255) * 8;
    float w0[8], w1[8], w2[8], w3[8], bb[8];
#pragma unroll
    for (int e = 0; e < 8; ++e) { w0[e] = w[c0 + e]; w1[e] = w[2048 + c0 + e]; w2[e] = w[4096 + c0 + e]; w3[e] = w[6144 + c0 + e]; bb[e] = bias[c0 + e]; }
    const int total = (T_ / 16) * 256;
    u32x4 nx[19];
    if (gt < total) {
        const int t0 = (gt >> 8) * 16; const bool first = (t0 & 2047) == 0;
#pragma unroll
        for (int r = 0; r < 19; ++r) { const int t = (first && r < 3) ? t0 : t0 - 3 + r; nx[r] = *(const u32x4*)(X + (size_t)t * 2048 + c0); }
    }
    for (int it = gt; it < total; it += stride) {
        const int t0 = (it >> 8) * 16; const bool first = (t0 & 2047) == 0;
        u32x4 cu[19];
#pragma unroll
        for (int r = 0; r < 19; ++r) cu[r] = nx[r];
        if (it + stride < total) {
            const int t1 = ((it + stride) >> 8) * 16; const bool f1 = (t1 & 2047) == 0;
#pragma unroll
            for (int r = 0; r < 19; ++r) { const int t = (f1 && r < 3) ? t1 : t1 - 3 + r; nx[r] = *(const u32x4*)(X + (size_t)t * 2048 + c0); }
        }
        float p3[8], p2[8], p1[8];
        unpack8(cu[0], p3); unpack8(cu[1], p2); unpack8(cu[2], p1);
        if (first) {
#pragma unroll
            for (int e = 0; e < 8; ++e) { p3[e] = 0.f; p2[e] = 0.f; p1[e] = 0.f; }
        }
#pragma unroll
        for (int r = 0; r < 16; ++r) {
            float cur[8], y[8];
            unpack8(cu[3 + r], cur);
#pragma unroll
            for (int e = 0; e < 8; ++e) { const float v = bb[e] + w0[e] * p3[e] + w1[e] * p2[e] + w2[e] * p1[e] + w3[e] * cur[e]; y[e] = silu_(v); p3[e] = p2[e]; p2[e] = p1[e]; p1[e] = cur[e]; }
            *(u32x4*)(Y + (size_t)(t0 + r) * 2048 + c0) = pack8f(y);
        }
    }
}

DI void gate_scan(const Params& p) {
    const int tid_ = opq(threadIdx.x), lane = tid_ & 63, wid = tid_ >> 6;
    const int bh = blockIdx.x * 8 + wid;
    if (bh >= 128) return;
    const float* LI = (const float*)(p.ws + WS_LI); const float* LF = (const float*)(p.ws + WS_LF);
    float* GP = (float*)(p.ws + WS_GP); float* GQ = (float*)(p.ws + WS_GQ); float* GD = (float*)(p.ws + WS_GD); float* GF = (float*)(p.ws + WS_GF); float* GW = (float*)(p.ws + WS_GW);
    float mcar = 0.f;
    float lfn = LF[(size_t)bh * S_ + lane], lin = LI[(size_t)bh * S_ + lane];
    for (int c = 0; c < 32; ++c) {
        const size_t o = (size_t)bh * S_ + c * 64 + lane;
        const float lf = lfn, li = lin;
        { const size_t on = (c < 31) ? o + 64 : o; lfn = LF[on]; lin = LI[on]; }
        float F = lf;
        F += __int_as_float(__builtin_amdgcn_update_dpp(0, __float_as_int(F), 0x111, 0xf, 0xf, false));
        F += __int_as_float(__builtin_amdgcn_update_dpp(0, __float_as_int(F), 0x112, 0xf, 0xf, false));
        F += __int_as_float(__builtin_amdgcn_update_dpp(0, __float_as_int(F), 0x114, 0xf, 0xf, false));
        F += __int_as_float(__builtin_amdgcn_update_dpp(0, __float_as_int(F), 0x118, 0xf, 0xf, false));
        { const int fi = __float_as_int(F); const float t0 = __int_as_float(__builtin_amdgcn_readlane(fi, 15)), t1 = __int_as_float(__builtin_amdgcn_readlane(fi, 31)), t2 = __int_as_float(__builtin_amdgcn_readlane(fi, 47));
          const int rw = lane >> 4; F += (rw >= 1 ? t0 : 0.f) + (rw >= 2 ? t1 : 0.f) + (rw >= 3 ? t2 : 0.f); }
        const float Qs = li - F;
        float Mx = Qs;
        { const int ninf = __float_as_int(-__builtin_inff());
          Mx = fmaxf(Mx, __int_as_float(__builtin_amdgcn_update_dpp(ninf, __float_as_int(Mx), 0x111, 0xf, 0xf, false)));
          Mx = fmaxf(Mx, __int_as_float(__builtin_amdgcn_update_dpp(ninf, __float_as_int(Mx), 0x112, 0xf, 0xf, false)));
          Mx = fmaxf(Mx, __int_as_float(__builtin_amdgcn_update_dpp(ninf, __float_as_int(Mx), 0x114, 0xf, 0xf, false)));
          Mx = fmaxf(Mx, __int_as_float(__builtin_amdgcn_update_dpp(ninf, __float_as_int(Mx), 0x118, 0xf, 0xf, false)));
          const int mi = __float_as_int(Mx); const float t0 = __int_as_float(__builtin_amdgcn_readlane(mi, 15)), t1 = __int_as_float(__builtin_amdgcn_readlane(mi, 31)), t2 = __int_as_float(__builtin_amdgcn_readlane(mi, 47));
          const int rw = lane >> 4; const float ninff = -__builtin_inff();
          Mx = fmaxf(Mx, fmaxf(fmaxf(rw >= 1 ? t0 : ninff, rw >= 2 ? t1 : ninff), rw >= 3 ? t2 : ninff)); }
        const float a = F + mcar, mt = fmaxf(a, F + Mx);
        const float P = F - mt;
        const float P63 = __int_as_float(__builtin_amdgcn_readlane(__float_as_int(P), 63));
        GP[o] = P; GQ[o] = Qs; GD[o] = __expf(a - mt); GF[o] = __expf(-mt); GW[o] = __expf(P63 + Qs);
        mcar = __int_as_float(__builtin_amdgcn_readlane(__float_as_int(mt), 63));
    }
}

template <int ST> DI bf16x8 pack_step(const f32x16& x) {
    u32x4 r; r[0] = pk2(x[8 * ST], x[8 * ST + 1]); r[1] = pk2(x[8 * ST + 2], x[8 * ST + 3]); r[2] = pk2(x[8 * ST + 4], x[8 * ST + 5]); r[3] = pk2(x[8 * ST + 6], x[8 * ST + 7]);
    return __builtin_bit_cast(bf16x8, r);
}
DI bf16x8 join4(const s16x4& lo, const s16x4& hi) { return __builtin_shufflevector(lo, hi, 0, 1, 2, 3, 4, 5, 6, 7); }
#define MFMA32(a, b, c) __builtin_amdgcn_mfma_f32_32x32x16_bf16((a), (b), (c), 0, 0, 0)
#define TRRD(ptr) __builtin_amdgcn_ds_read_tr16_b64_v4i16((LAS s16x4*)(ptr))

DI void phase_mlstm(const Params& p, unsigned char* shm, const int vb) {
    LAS unsigned char* lds = (LAS unsigned char*)shm;
    constexpr int RS = 528, QI = 0, KI = 64 * RS, VI = KI + 80 * RS, SMI = VI + 64 * RS, SMS = 144;
    constexpr int NS = SMI + 64 * SMS, NACC = NS + 1024, QN = NACC + 1024, RSUM = QN + 256, PC = RSUM + 256, QC = PC + 256, DEC = QC + 256, FLR = DEC + 256, WL = FLR + 256;
    constexpr int PNB = WL + 256;
    static_assert(PNB + 16384 <= LDS_BYTES - 64, "lds");
    const int w = __builtin_amdgcn_readfirstlane(threadIdx.x >> 6);
    const bf16_t* Q = (const bf16_t*)p.out; const bf16_t* Kp = Q + (size_t)T_ * 1024; const bf16_t* V = (const bf16_t*)(p.ws + WS_RC);
    bf16_t* H = (bf16_t*)(p.ws + WS_RA);
    const float* GP = (const float*)(p.ws + WS_GP); const float* GQ = (const float*)(p.ws + WS_GQ); const float* GD = (const float*)(p.ws + WS_GD);
    const float* GF = (const float*)(p.ws + WS_GF); const float* GW = (const float*)(p.ws + WS_GW);
    LAS float* n_s = (LAS float*)(lds + NS); LAS float* nacc = (LAS float*)(lds + NACC); LAS float* qn = (LAS float*)(lds + QN); LAS float* rsum = (LAS float*)(lds + RSUM);
    LAS float* wls = (LAS float*)(lds + WL);
    LAS float* Pc = (LAS float*)(lds + PC); LAS float* Qc = (LAS float*)(lds + QC); LAS float* dec = (LAS float*)(lds + DEC); LAS float* flr = (LAS float*)(lds + FLR);
    for (int unit = vb; unit < 256; unit += gridDim.x) {
        const int bh = (unit & 7) * 16 + (unit >> 4), half = (unit >> 3) & 1, b = bh >> 2, h = bh & 3;
        f32x16 C[8];
        unsigned pf0 = 0u, pf1 = 0u;
#pragma unroll
        for (int i = 0; i < 8; ++i)
#pragma unroll
            for (int e = 0; e < 16; ++e) C[i][e] = 0.f;
        if (threadIdx.x < 256) { n_s[threadIdx.x] = 0.f; nacc[threadIdx.x] = 0.f; }
        { const int tid = threadIdx.x; if (tid < 480) *(LAS u32x4*)(lds + KI + (65 + (tid >> 5)) * RS + 16 * (tid & 31)) = (u32x4){0u, 0u, 0u, 0u}; }
        for (int c = 0; c < 32; ++c) {
            __syncthreads();
            asm volatile("" :: "v"(pf0), "v"(pf1));
            const int t0 = b * S_ + c * 64; const size_t gbase = (size_t)bh * S_ + c * 64;
            {
                const int tid = opq(threadIdx.x), r4 = tid >> 5, cgp = tid & 31;
                if (tid < 64) { Pc[tid] = GP[gbase + tid]; Qc[tid] = GQ[gbase + tid]; dec[tid] = GD[gbase + tid]; flr[tid] = GF[gbase + tid]; wls[tid] = GW[gbase + tid]; rsum[tid] = 0.f; }
                float pn[8];
#pragma unroll
                for (int e = 0; e < 8; ++e) pn[e] = 0.f;
                if (tid < 32) {
                    const f32x4 n0 = *(const LAS f32x4*)(n_s + 8 * cgp), n1 = *(const LAS f32x4*)(n_s + 8 * cgp + 4);
                    u32x4 nb; nb[0] = pk2(n0[0], n0[1]); nb[1] = pk2(n0[2], n0[3]); nb[2] = pk2(n1[0], n1[1]); nb[3] = pk2(n1[2], n1[3]);
                    *(LAS u32x4*)(lds + KI + 64 * RS + 16 * cgp) = nb;
                }
                const bf16_t* qp = Q + (size_t)(t0 + r4) * 1024 + h * 256 + 8 * cgp;
                const bf16_t* kp = Kp + (size_t)(t0 + r4) * 1024 + h * 256 + 8 * cgp;
                const bf16_t* vp = V + (size_t)(t0 + r4) * 2048 + h * 512 + half * 256 + 8 * cgp;
                const int lo_ = r4 * RS + 16 * cgp;
#pragma unroll
                for (int i = 0; i < 4; ++i) {
                    const u32x4 qv = *(const u32x4*)(qp + (size_t)i * 16 * 1024);
                    const u32x4 kv = *(const u32x4*)(kp + (size_t)i * 16 * 1024);
                    const u32x4 vv = *(const u32x4*)(vp + (size_t)i * 16 * 2048);
                    const float wl = GW[gbase + r4 + 16 * i];
                    *(LAS u32x4*)(lds + QI + lo_ + i * 16 * RS) = qv;
                    *(LAS u32x4*)(lds + KI + lo_ + i * 16 * RS) = kv;
                    *(LAS u32x4*)(lds + VI + lo_ + i * 16 * RS) = vv;
                    float f[8];
                    unpack8(kv, f);
#pragma unroll
                    for (int e = 0; e < 8; ++e) pn[e] += wl * f[e];
                }
                *(LAS f32x4*)(lds + PNB + r4 * 1024 + cgp * 32) = (f32x4){pn[0], pn[1], pn[2], pn[3]};
                *(LAS f32x4*)(lds + PNB + r4 * 1024 + cgp * 32 + 16) = (f32x4){pn[4], pn[5], pn[6], pn[7]};
            }
            __syncthreads();
            if (c < 31) {
                const int tid = opq(threadIdx.x), rr = (tid & 255) >> 2, sg = tid & 3;
                const bf16_t* qk = (tid < 256 ? Q : Kp) + (size_t)(t0 + 64 + rr) * 1024 + h * 256 + sg * 64;
                pf0 = *(const unsigned*)qk;
                if (tid < 256) pf1 = *(const unsigned*)(V + (size_t)(t0 + 64 + rr) * 2048 + h * 512 + half * 256 + sg * 64);
            }
            const float d_last = dec[63];
            if (threadIdx.x < 256) { const int tid = threadIdx.x; float a = 0.f;
#pragma unroll
                for (int g = 0; g < 16; ++g) a += *(const LAS float*)(lds + PNB + g * 1024 + tid * 4);
                n_s[tid] = d_last * n_s[tid] + a; }
            {
                const int lane = opq(threadIdx.x) & 63, fr = lane & 15, fq = lane >> 4;
                const int ti = w & 3;
#pragma unroll
                for (int z = 0; z < 2; ++z) {
                    const int si = 2 * (w >> 2) + z;
                    f32x4 a4 = {0.f, 0.f, 0.f, 0.f};
                    if (si <= ti) {
                        const int ka = KI + (16 * si + fr) * RS + 16 * fq, qa = QI + (16 * ti + fr) * RS + 16 * fq;
#pragma unroll
                        for (int kk = 0; kk < 8; ++kk) {
                            const bf16x8 af = *(const LAS bf16x8*)(lds + ka + 64 * kk);
                            const bf16x8 bq = *(const LAS bf16x8*)(lds + qa + 64 * kk);
                            a4 = __builtin_amdgcn_mfma_f32_16x16x32_bf16(af, bq, a4, 0, 0, 0);
                        }
                        const int t = 16 * ti + fr; const float Pt = Pc[t];
                        const f32x4 qs = *(const LAS f32x4*)(Qc + 16 * si + 4 * fq);
                        float rsm = 0.f;
#pragma unroll
                        for (int j = 0; j < 4; ++j) { const int s = 16 * si + 4 * fq + j; const float wg = (s <= t) ? __expf(Pt + qs[j]) : 0.f; a4[j] *= wg; rsm += a4[j]; }
                        rsm += __shfl_xor(rsm, 16); rsm += __shfl_xor(rsm, 32);
                        if (fq == 0) __hip_atomic_fetch_add((float*)(shm + RSUM) + t, rsm, __ATOMIC_RELAXED, __HIP_MEMORY_SCOPE_WORKGROUP);
                    }
                    u32x2 sm; sm[0] = pk2(a4[0], a4[1]); sm[1] = pk2(a4[2], a4[3]);
                    *(LAS u32x2*)(lds + SMI + (16 * ti + fr) * SMS + (16 * si + 4 * fq) * 2) = sm;
                }
                if (w == 4 || w == 5) {
#pragma unroll
                    for (int z = 0; z < 2; ++z) {
                        const int tn = 2 * (w - 4) + z;
                        const int ka = KI + (64 + fr) * RS + 16 * fq, qa = QI + (16 * tn + fr) * RS + 16 * fq;
                        f32x4 a4 = {0.f, 0.f, 0.f, 0.f};
#pragma unroll
                        for (int kk = 0; kk < 8; ++kk) {
                            const bf16x8 af = *(const LAS bf16x8*)(lds + ka + 64 * kk);
                            const bf16x8 bq = *(const LAS bf16x8*)(lds + qa + 64 * kk);
                            a4 = __builtin_amdgcn_mfma_f32_16x16x32_bf16(af, bq, a4, 0, 0, 0);
                        }
                        if (fq == 0) qn[16 * tn + fr] = a4[0];
                    }
                }
            }
            __builtin_amdgcn_sched_barrier(0);
            f32x16 acc2[2];
#pragma unroll
            for (int m = 0; m < 2; ++m)
#pragma unroll
                for (int e = 0; e < 16; ++e) acc2[m][e] = 0.f;
            {
                const int lane = opq(threadIdx.x) & 63, l32 = lane & 31, hh = lane >> 5;
                const int qb = QI + l32 * RS + 8 * hh;
#pragma unroll
                for (int ci = 0; ci < 8; ++ci) {
                    s16x4 lo[2][2], hi[2][2];
#pragma unroll
                    for (int st = 0; st < 2; ++st)
#pragma unroll
                        for (int m2 = 0; m2 < 2; ++m2) { const int off = qb + 32 * m2 * RS + 64 * ci + 32 * st;
                            lo[st][m2] = *(const LAS s16x4*)(lds + off); hi[st][m2] = *(const LAS s16x4*)(lds + off + 16); }
                    const bf16x8 bf0 = pack_step<0>(C[ci]), bf1 = pack_step<1>(C[ci]);
                    __builtin_amdgcn_sched_barrier(0);
#pragma unroll
                    for (int m2 = 0; m2 < 2; ++m2) acc2[m2] = MFMA32(join4(lo[0][m2], hi[0][m2]), bf0, acc2[m2]);
#pragma unroll
                    for (int m2 = 0; m2 < 2; ++m2) acc2[m2] = MFMA32(join4(lo[1][m2], hi[1][m2]), bf1, acc2[m2]);
                    __builtin_amdgcn_sched_barrier(0);
                }
            }
            __syncthreads();
            {
                const int lane = opq(threadIdx.x) & 63, l32 = lane & 31, hh = lane >> 5, q4 = (lane & 15) >> 2, p4 = lane & 3, blk = (lane >> 4) & 1;
#pragma unroll
                for (int m = 0; m < 2; ++m)
#pragma unroll
                    for (int g = 0; g < 4; ++g) { const f32x4 d4 = *(const LAS f32x4*)(dec + 32 * m + 8 * g + 4 * hh);
#pragma unroll
                        for (int e = 0; e < 4; ++e) acc2[m][4 * g + e] *= d4[e]; }
                const int vb = VI + (8 * hh + q4) * RS + (32 * w + 16 * blk) * 2 + 8 * p4, sb = SMI + l32 * SMS + 16 * hh;
#pragma unroll
                for (int kk = 0; kk < 4; ++kk) {
                    const s16x4 lo = TRRD(lds + vb + 16 * kk * RS), hi = TRRD(lds + vb + 16 * kk * RS + 4 * RS);
                    const bf16x8 bf = join4(lo, hi);
#pragma unroll
                    for (int m = 0; m < 2; ++m) { const bf16x8 af = *(const LAS bf16x8*)(lds + sb + 32 * m * SMS + 32 * kk); acc2[m] = MFMA32(af, bf, acc2[m]); }
                }
                const int hb = QI + 4 * hh * RS + (32 * w + l32) * 2;
#pragma unroll
                for (int m = 0; m < 2; ++m)
#pragma unroll
                    for (int g = 0; g < 4; ++g) {
                        const int rb = 32 * m + 8 * g;
                        const f32x4 d4 = *(const LAS f32x4*)(dec + rb + 4 * hh), n4 = *(const LAS f32x4*)(qn + rb + 4 * hh), s4 = *(const LAS f32x4*)(rsum + rb + 4 * hh), f4 = *(const LAS f32x4*)(flr + rb + 4 * hh);
#pragma unroll
                        for (int e = 0; e < 4; ++e) {
                            const float den = d4[e] * n4[e] + s4[e];
                            const float val = acc2[m][4 * g + e] * __builtin_amdgcn_rcpf(fmaxf(fabsf(den), f4[e]));
                            *(LAS bf16_t*)(lds + hb + (rb + e) * RS) = (bf16_t)(pk2(val, 0.f) & 0xffffu);
                        }
                    }
            }
            __builtin_amdgcn_sched_barrier(0);
            {
                const int lane = opq(threadIdx.x) & 63, hh = lane >> 5, q4 = (lane & 15) >> 2, p4 = lane & 3, blk = (lane >> 4) & 1;
                const int tb = (8 * hh + q4) * RS + 32 * blk + 8 * p4;
                bf16x8 bw[4];
#pragma unroll
                for (int kk = 0; kk < 4; ++kk) { const int voff = VI + tb + 64 * w + 16 * kk * RS;
                    const bf16x8 raw = join4(TRRD(lds + voff), TRRD(lds + voff + 4 * RS));
                    const f32x4 w0 = *(const LAS f32x4*)(wls + 16 * kk + 8 * hh), w1 = *(const LAS f32x4*)(wls + 16 * kk + 8 * hh + 4);
                    float f[8]; unpack8(__builtin_bit_cast(u32x4, raw), f);
#pragma unroll
                    for (int e = 0; e < 4; ++e) { f[e] *= w0[e]; f[4 + e] *= w1[e]; }
                    bw[kk] = __builtin_bit_cast(bf16x8, pack8f(f)); }
#pragma unroll
                for (int ci = 0; ci < 8; ++ci) {
                    bf16x8 ka[4];
#pragma unroll
                    for (int kk = 0; kk < 4; ++kk) { const int koff = KI + tb + 64 * ci + 16 * kk * RS; ka[kk] = join4(TRRD(lds + koff), TRRD(lds + koff + 4 * RS)); }
#pragma unroll
                    for (int e = 0; e < 16; ++e) C[ci][e] *= d_last;
                    __builtin_amdgcn_sched_barrier(0);
#pragma unroll
                    for (int kk = 0; kk < 4; ++kk) C[ci] = MFMA32(ka[kk], bw[kk], C[ci]);
                    __builtin_amdgcn_sched_barrier(0);
                }
            }
            __syncthreads();
            {
                const int tid = opq(threadIdx.x), r4 = tid >> 5, cgp = tid & 31;
                bf16_t* hp = H + (size_t)(t0 + r4) * 2048 + h * 512 + half * 256 + 8 * cgp;
#pragma unroll
                for (int i = 0; i < 4; ++i) *(u32x4*)(hp + (size_t)i * 16 * 2048) = *(const LAS u32x4*)(lds + QI + (r4 + 16 * i) * RS + 16 * cgp);
            }
        }
        __syncthreads();
    }
}


DI void phase_post(const Params& p) {
    const int tid_ = opq(threadIdx.x), lane = tid_ & 63, wid = tid_ >> 6;
    const int gw = blockIdx.x * 8 + wid, nw = gridDim.x * 8;
    bf16_t* H = (bf16_t*)(p.ws + WS_RA); const unsigned char* O = (const unsigned char*)p.out; const bf16_t* XC = (const bf16_t*)(p.ws + WS_RB); const bf16_t* Z = (const bf16_t*)(p.ws + WS_RC);
    const float* nwp = p.in[11]; const float* skp = p.in[12];
    u32x4 nh, nx, nz; u32x2 no;
    { const size_t b0 = (size_t)(gw >> 2) * 2048 + (gw & 3) * 512 + lane * 8; nh = *(const u32x4*)(H + b0); no = *(const u32x2*)(O + b0); nx = *(const u32x4*)(XC + b0); nz = *(const u32x4*)(Z + b0); }
    for (int u = gw; u < T_ * 4; u += nw) {
        const int hd = u & 3; const size_t base = (size_t)(u >> 2) * 2048 + hd * 512 + lane * 8;
        float hv[8], ov[8], xv[8], zv[8];
        unpack8(nh, hv); unpack_fp8x8(no, ov); unpack8(nx, xv); unpack8(nz, zv);
        { const int un = (u + nw < T_ * 4) ? u + nw : u; const size_t bn = (size_t)(un >> 2) * 2048 + (un & 3) * 512 + lane * 8;
          nh = *(const u32x4*)(H + bn); no = *(const u32x2*)(O + bn); nx = *(const u32x4*)(XC + bn); nz = *(const u32x4*)(Z + bn); }
        float s = 0.f;
#pragma unroll
        for (int e = 0; e < 8; ++e) { hv[e] *= sigm(ov[e]); s += hv[e]; }
        const float mu = wave_sum(s) * (1.f / 512.f);
        float s2 = 0.f;
#pragma unroll
        for (int e = 0; e < 8; ++e) { hv[e] -= mu; s2 += hv[e] * hv[e]; }
        const float r = __builtin_amdgcn_rsqf(wave_sum(s2) * (1.f / 512.f) + EPS_);
        const f32x4 nw0 = *(const f32x4*)(nwp + hd * 512 + lane * 8), nw1 = *(const f32x4*)(nwp + hd * 512 + lane * 8 + 4);
        const f32x4 sk0 = *(const f32x4*)(skp + hd * 512 + lane * 8), sk1 = *(const f32x4*)(skp + hd * 512 + lane * 8 + 4);
        float y[8];
#pragma unroll
        for (int e = 0; e < 4; ++e) { y[e] = (hv[e] * r * nw0[e] + sk0[e] * xv[e]) * silu_(zv[e]); y[4 + e] = (hv[4 + e] * r * nw1[e] + sk1[e] * xv[4 + e]) * silu_(zv[4 + e]); }
        *(u32x4*)(H + base) = pack8f(y);
    }
}

DI void phase_scan(const Params& p, unsigned char* shm) {
    LAS unsigned char* lds = (LAS unsigned char*)shm;
    constexpr int TR = 400, TSZ = 64 * TR;
    const bf16_t* LA = (const bf16_t*)(p.ws + WS_LA); const bf16_t* BT = (const bf16_t*)(p.ws + WS_BT); const bf16_t* G = (const bf16_t*)(p.ws + WS_RC);
    bf16_t* Y = (bf16_t*)(p.ws + WS_RB);
    const int tid = opq(threadIdx.x);
    for (int unit = blockIdx.x; unit < 256; unit += gridDim.x) {
        const int b = unit >> 3, cg0 = (unit & 7) * 192;
        int goff[3], loff[3];
#pragma unroll
        for (int j = 0; j < 3; ++j) { const int q = tid + 512 * j, row = q / 24, cc = q % 24; goff[j] = row * 1536 + cc * 8; loff[j] = row * TR + cc * 16; }
        const size_t base = (size_t)b * S_ * 1536 + cg0;
        u32x4 ra[3], rb[3], rg[3];
#pragma unroll
        for (int j = 0; j < 3; ++j) { ra[j] = *(const u32x4*)(LA + base + goff[j]); rb[j] = *(const u32x4*)(BT + base + goff[j]); rg[j] = *(const u32x4*)(G + base + goff[j]); }
        float hst = 0.f;
        for (int tile = 0; tile < 32; ++tile) {
            __syncthreads();
#pragma unroll
            for (int j = 0; j < 3; ++j) { *(LAS u32x4*)(lds + loff[j]) = ra[j]; *(LAS u32x4*)(lds + TSZ + loff[j]) = rb[j]; *(LAS u32x4*)(lds + 2 * TSZ + loff[j]) = rg[j]; }
            if (tile < 31) {
                const size_t nb = base + (size_t)(tile + 1) * 64 * 1536;
#pragma unroll
                for (int j = 0; j < 3; ++j) { ra[j] = *(const u32x4*)(LA + nb + goff[j]); rb[j] = *(const u32x4*)(BT + nb + goff[j]); rg[j] = *(const u32x4*)(G + nb + goff[j]); }
            }
            __syncthreads();
            if (tid < 192) {
#pragma unroll 8
                for (int r = 0; r < 64; ++r) {
                    const float la = __uint_as_float((unsigned)*(const LAS bf16_t*)(lds + r * TR + tid * 2) << 16);
                    const float bt = __uint_as_float((unsigned)*(const LAS bf16_t*)(lds + TSZ + r * TR + tid * 2) << 16);
                    const float g = __uint_as_float((unsigned)*(const LAS bf16_t*)(lds + 2 * TSZ + r * TR + tid * 2) << 16);
                    hst = __expf(la) * hst + bt;
                    *(LAS bf16_t*)(lds + 2 * TSZ + r * TR + tid * 2) = (bf16_t)(pk2(hst * g, 0.f) & 0xffffu);
                }
            }
            __syncthreads();
            const size_t ob = base + (size_t)tile * 64 * 1536;
#pragma unroll
            for (int j = 0; j < 3; ++j) *(u32x4*)(Y + ob + goff[j]) = *(const LAS u32x4*)(lds + 2 * TSZ + loff[j]);
        }
        __syncthreads();
    }
}

DI void phase_rglru(const Params& p, unsigned char* shm) {
    LAS unsigned char* lds = (LAS unsigned char*)shm;
    constexpr int TR = 400, XR = 0, XC = 26880, GT = XC + 25600, LAo = GT + 25600, BTo = LAo + 25600, CW = BTo + 25600, GB = CW + 3840;
    static_assert(GB + 2304 <= LDS_BYTES, "lds");
    const int tid = opq(threadIdx.x), lane = tid & 63, w = __builtin_amdgcn_readfirstlane(tid >> 6), fr = lane & 15, fq = lane >> 4;
    const bf16_t* XRg = (const bf16_t*)(p.ws + WS_RA); const bf16_t* Gg = (const bf16_t*)(p.ws + WS_RC); bf16_t* Y = (bf16_t*)(p.ws + WS_RB);
    const bf16_t* WG2 = (const bf16_t*)(p.ws + WS_WT_G); const float* SPp = (const float*)(p.ws + WS_SP);
    LAS float* cw = (LAS float*)(lds + CW); LAS float* gb = (LAS float*)(lds + GB);
    for (int unit = blockIdx.x; unit < 256; unit += gridDim.x) {
        const int b = unit >> 3, blk = unit & 7, cg0 = blk * 192;
        __syncthreads();
        for (int i = tid; i < 960; i += 512) { const int j = i / 192, c = i % 192; cw[i] = j < 4 ? p.in[15][j * 1536 + cg0 + c] : p.in[16][cg0 + c]; }
        for (int i = tid; i < 576; i += 512) { const int k = i / 192, c = i % 192; gb[i] = (k == 0 ? p.in[18] : (k == 1 ? p.in[20] : SPp))[cg0 + c]; }
        if (tid < 72) *(LAS u32x4*)(lds + XR + (tid / 24) * TR + (tid % 24) * 16) = (u32x4){0u, 0u, 0u, 0u};
        bf16x8 Bf[4][6];
        const int chb = w < 4 ? 32 * w : 128 + 16 * (w - 4);
        {
#pragma unroll
          for (int nt = 0; nt < 4; ++nt)
#pragma unroll
              for (int kk = 0; kk < 6; ++kk) {
                  const int chn = chb + ((w < 4) ? 16 * (nt & 1) : 0) + fr;
                  Bf[nt][kk] = *(const bf16x8*)(WG2 + ((size_t)((blk * 2 + (nt >> 1)) * 192 + chn) * 192 + 32 * kk + 8 * fq)); } }
        int goff[3], loff[3];
#pragma unroll
        for (int j = 0; j < 3; ++j) { const int q = tid + 512 * j, row = q / 24, cc = q % 24; goff[j] = row * 1536 + cc * 8; loff[j] = row * TR + cc * 16; }
        const size_t base = (size_t)b * S_ * 1536 + cg0;
        u32x4 rx[3], rg[3];
#pragma unroll
        for (int j = 0; j < 3; ++j) { rx[j] = *(const u32x4*)(XRg + base + goff[j]); rg[j] = *(const u32x4*)(Gg + base + goff[j]); }
        float hst = 0.f;
        for (int tile = 0; tile < 32; ++tile) {
            __syncthreads();
#pragma unroll
            for (int j = 0; j < 3; ++j) { *(LAS u32x4*)(lds + XR + 3 * TR + loff[j]) = rx[j]; *(LAS u32x4*)(lds + GT + loff[j]) = rg[j]; }
            if (tile < 31) {
                const size_t nb = base + (size_t)(tile + 1) * 64 * 1536;
#pragma unroll
                for (int j = 0; j < 3; ++j) { rx[j] = *(const u32x4*)(XRg + nb + goff[j]); rg[j] = *(const u32x4*)(Gg + nb + goff[j]); }
            }
            __syncthreads();
#pragma unroll
            for (int j = 0; j < 3; ++j) {
                const int q = tid + 512 * j, cc = q % 24;
                float a8[8];
                { const f32x4 b0 = *(const LAS f32x4*)(cw + 768 + 8 * cc), b1 = *(const LAS f32x4*)(cw + 768 + 8 * cc + 4);
#pragma unroll
                  for (int e = 0; e < 4; ++e) { a8[e] = b0[e]; a8[4 + e] = b1[e]; } }
#pragma unroll
                for (int jj = 0; jj < 4; ++jj) {
                    float xin[8]; { const u32x4 xraw = *(const LAS u32x4*)(lds + XR + jj * TR + loff[j]); unpack8(xraw, xin); }
                    const f32x4 w0 = *(const LAS f32x4*)(cw + jj * 192 + 8 * cc), w1 = *(const LAS f32x4*)(cw + jj * 192 + 8 * cc + 4);
#pragma unroll
                    for (int e = 0; e < 4; ++e) { a8[e] += w0[e] * xin[e]; a8[4 + e] += w1[e] * xin[4 + e]; }
                }
                *(LAS u32x4*)(lds + XC + loff[j]) = pack8f(a8);
            }
            __syncthreads();
            {
#pragma unroll
                for (int u = 0; u < 2; ++u) {
                    if (u == 1 && w >= 4) break;
                    f32x4 acc[4][2];
#pragma unroll
                    for (int mt = 0; mt < 4; ++mt) { acc[mt][0] = (f32x4){0.f, 0.f, 0.f, 0.f}; acc[mt][1] = (f32x4){0.f, 0.f, 0.f, 0.f}; }
#pragma unroll
                    for (int kk = 0; kk < 6; ++kk)
#pragma unroll
                        for (int mt = 0; mt < 4; ++mt) {
                            const bf16x8 af = *(const LAS bf16x8*)(lds + XC + (16 * mt + fr) * TR + (32 * kk + 8 * fq) * 2);
                            acc[mt][0] = __builtin_amdgcn_mfma_f32_16x16x32_bf16(af, Bf[u][kk], acc[mt][0], 0, 0, 0);
                            acc[mt][1] = __builtin_amdgcn_mfma_f32_16x16x32_bf16(af, Bf[2 + u][kk], acc[mt][1], 0, 0, 0);
                        }
                    const int ch = chb + 16 * u + fr;
                    const float ba = gb[ch], bx = gb[192 + ch], sp = gb[384 + ch];
#pragma unroll
                    for (int mt = 0; mt < 4; ++mt)
#pragma unroll
                        for (int j = 0; j < 4; ++j) {
                            const int t = 16 * mt + 4 * fq + j;
                            const float ea = 1.f + __expf(fminf(-(acc[mt][0][j] + ba), 40.f)), ex = 1.f + __expf(fminf(-(acc[mt][1][j] + bx), 40.f));
                            const float inv = __builtin_amdgcn_rcpf(ea * ex);
                            const float r = inv * ex, ig = inv * ea;
                            const float av = __expf(r * sp), om = 1.f - av;
                            const float xcv = __uint_as_float((unsigned)*(const LAS bf16_t*)(lds + XC + t * TR + ch * 2) << 16);
                            const float bt = __builtin_amdgcn_sqrtf(fmaxf(om * (1.f + av), 0.f)) * (ig * xcv);
                            *(LAS bf16_t*)(lds + LAo + t * TR + ch * 2) = (bf16_t)(pk2(om, 0.f) & 0xffffu);
                            *(LAS bf16_t*)(lds + BTo + t * TR + ch * 2) = (bf16_t)(pk2(bt, 0.f) & 0xffffu);
                        }
                    __builtin_amdgcn_sched_barrier(0);
                }
            }
            __syncthreads();
            if (tid < 192) {
#pragma unroll 8
                for (int r = 0; r < 64; ++r) {
                    const float om = __uint_as_float((unsigned)*(const LAS bf16_t*)(lds + LAo + r * TR + tid * 2) << 16);
                    const float bt = __uint_as_float((unsigned)*(const LAS bf16_t*)(lds + BTo + r * TR + tid * 2) << 16);
                    const float g = __uint_as_float((unsigned)*(const LAS bf16_t*)(lds + GT + r * TR + tid * 2) << 16);
                    hst = (hst - om * hst) + bt;
                    *(LAS bf16_t*)(lds + GT + r * TR + tid * 2) = (bf16_t)(pk2(hst * g, 0.f) & 0xffffu);
                }
            } else if (tid >= 256 && tid < 328) {
                const int i = tid - 256, r = i / 24, cc = i % 24;
                const u32x4 v = *(const LAS u32x4*)(lds + XR + (64 + r) * TR + cc * 16);
                *(LAS u32x4*)(lds + XR + r * TR + cc * 16) = v;
            }
            __syncthreads();
            const size_t ob = base + (size_t)tile * 64 * 1536;
#pragma unroll
            for (int j = 0; j < 3; ++j) *(u32x4*)(Y + ob + goff[j]) = *(const LAS u32x4*)(lds + GT + loff[j]);
        }
        __syncthreads();
    }
}


#define XB_TMO      128
#define XB_XCNT(j)  (256  + 64 * (j))
#define XB_XSUB(j)  (1280 + 64 * (j))
#define XB_XGEN(j)  (2304 + 64 * (j))
#define XB_TOP      3328
#define XB_TOPGEN   3392
#define XCD_BAR_WORDS 3456
#define XB_SPIN_CAP (1u << 18)
DI unsigned xb_ld(unsigned* p)              { return __hip_atomic_load(p, __ATOMIC_RELAXED, __HIP_MEMORY_SCOPE_AGENT); }
DI unsigned xb_add(unsigned* p, unsigned v) { return __hip_atomic_fetch_add(p, v, __ATOMIC_RELAXED, __HIP_MEMORY_SCOPE_AGENT); }
DI unsigned xb_xcc_id() { return (unsigned)__builtin_amdgcn_s_getreg((3 << 11) | 20) & 0xFu; }
#define XB_SPIN(cond, bar) do { unsigned _sp = 0; while (cond) { __builtin_amdgcn_s_sleep(1); \
    if ((++_sp & 255u) == 0u) { if (xb_ld(&(bar)[XB_TMO])) break; if (_sp > XB_SPIN_CAP) { atomicAdd(&(bar)[XB_TMO], 1u); break; } } } } while (0)
struct XcdBarrier { unsigned* bar; unsigned x; volatile LAS unsigned* st; };
DI XcdBarrier xcd_barrier_post(unsigned* bar, volatile LAS unsigned* st) {
    XcdBarrier b; b.bar = bar; b.x = xb_xcc_id(); b.st = st;
    if (threadIdx.x == 0) st[2] = xb_add(&bar[XB_XCNT(b.x)], 1u);
    return b;
}
DI void xcd_barrier_complete(unsigned* bar, unsigned x, unsigned& nloc, unsigned& nx) {
    const unsigned G = gridDim.x * gridDim.y * gridDim.z;
    unsigned sum, cnt, mine, sp = 0u;
    for (;;) {
        sum = 0u; cnt = 0u; mine = 0u;
#pragma unroll
        for (unsigned j = 0; j < 16; ++j) { const unsigned c = xb_ld(&bar[XB_XCNT(j)]); sum += c; cnt += (c > 0u) ? 1u : 0u; mine = (j == x) ? c : mine; }
        if (sum == G) break;
        __builtin_amdgcn_s_sleep(1);
        if ((++sp & 255u) == 0u) { if (xb_ld(&bar[XB_TMO])) break; if (sp > XB_SPIN_CAP) { atomicAdd(&bar[XB_TMO], 1u); break; } }
    }
    nloc = mine > 0u ? mine : 1u; nx = cnt > 0u ? cnt : 1u;
}
DI void xcd_barrier(const XcdBarrier& b) {
    asm volatile("s_waitcnt vmcnt(0)" ::: "memory");
    __syncthreads();
    if (threadIdx.x == 0) {
        unsigned* bar = b.bar;
        __builtin_amdgcn_s_waitcnt(0);
        unsigned nloc = b.st[0], nx = b.st[1];
        if (nloc == 0u) { xcd_barrier_complete(bar, b.x, nloc, nx); b.st[0] = nloc; b.st[1] = nx; }
        const unsigned old = xb_add(&bar[XB_XSUB(b.x)], 1u);
        const unsigned gen = old / nloc;
        if (old + 1u == (gen + 1u) * nloc) {
            __builtin_amdgcn_fence(__ATOMIC_RELEASE, "agent");
            asm volatile("s_waitcnt vmcnt(0)" ::: "memory");
            const unsigned og = xb_add(&bar[XB_TOP], 1u);
            const unsigned tg = og / nx;
            if (og + 1u == (tg + 1u) * nx) xb_add(&bar[XB_TOPGEN], 1u);
            else XB_SPIN(xb_ld(&bar[XB_TOPGEN]) == tg, bar);
            __builtin_amdgcn_fence(__ATOMIC_ACQUIRE, "agent");
            xb_add(&bar[XB_XGEN(b.x)], 1u);
            asm volatile("s_waitcnt vmcnt(0)" ::: "memory");
        } else {
            XB_SPIN(xb_ld(&bar[XB_XGEN(b.x)]) == gen, bar);
            __builtin_amdgcn_fence(__ATOMIC_ACQUIRE, "agent");
            asm volatile("s_waitcnt vmcnt(0)" ::: "memory");
        }
    }
    __syncthreads();
}

__global__ void __launch_bounds__(512) hybrid_fwd(Params p) {
    extern __shared__ __attribute__((aligned(16))) unsigned char shm[];
    LAS unsigned char* lds = (LAS unsigned char*)shm;
    cg::grid_group grid = cg::this_grid();
    volatile LAS unsigned* xst = (volatile LAS unsigned*)(lds + 140272);
    if (threadIdx.x == 0) { xst[0] = 0u; xst[1] = 0u; }
    __syncthreads();
    if (blockIdx.x == 0) { unsigned* bw = (unsigned*)(p.ws + WS_BAR); for (int i = threadIdx.x; i < XCD_BAR_WORDS; i += 512) bw[i] = 0u; }
    grid.sync();
    XcdBarrier xb = xcd_barrier_post((unsigned*)(p.ws + WS_BAR), xst);
    unsigned char* ws = p.ws;
    bf16_t* U = (bf16_t*)(ws + WS_U); bf16_t* RA = (bf16_t*)(ws + WS_RA); bf16_t* RB = (bf16_t*)(ws + WS_RB); bf16_t* RC = (bf16_t*)(ws + WS_RC);
    bf16_t* OUTB = (bf16_t*)p.out;

    PH_BEGIN(0)
    phase_prep(p, shm);
    PH_END
    int vb;
    { if (threadIdx.x == 0) {
          unsigned* bw = (unsigned*)(p.ws + WS_BAR); bool ok = (gridDim.x % 8u) == 0u && xb.x < 8u;
          for (unsigned j = 0; j < 8; ++j) ok = ok && (xb_ld(&bw[XB_XCNT(j)]) == gridDim.x / 8u);
          xst[3] = ok ? (xst[2] * 8u + xb.x) : blockIdx.x; }
      __syncthreads();
      vb = __builtin_amdgcn_readfirstlane((int)xst[3]); }
    PH_BEGIN(1)
    { const char* A = (const char*)U; const char* B = (const char*)(ws + WS_WT_XM);
      gemm_phase<true>(lds, 256, 8, 1024, 1024, 1024,
          [=](int pm, int pn, const char*& a, const char*& b) { a = A + (size_t)pm * 256 * 1024 * 2; b = B + (size_t)pn * 256 * 1024 * 2; },
          [=](const f32x4 (&acc)[2][2][4][2], int pm, int pn, int wr, int wc, int fr, int fq) { epi_bf16<0>(acc, RA + (size_t)pm * 256 * 2048 + pn * 256, 2048, wr, wc, fr, fq); }, vb); }
    PH_END
    PH_BEGIN(2)
    if (blockIdx.x < 16) gate_scan(p);
    conv0_phase(RA, p.in[4], p.in[5], RB);
    PH_END
    PH_BEGIN(3)
    { const char* XC = (const char*)RB; const char* XM = (const char*)RA; const char* WQK = (const char*)(ws + WS_WT_QK); const char* WV = (const char*)(ws + WS_WT_V);
      gemm_phase<true>(lds, 256, 16, 512, 2048, 512,
          [=](int pm, int pn, const char*& a, const char*& b) {
              if (pn < 8) { a = XC + ((size_t)pm * 256 * 2048 + (pn >> 1) * 512) * 2; b = WQK + (size_t)pn * 256 * 512 * 2; }
              else { a = XM + ((size_t)pm * 256 * 2048 + ((pn - 8) >> 1) * 512) * 2; b = WV + (size_t)(pn - 8) * 256 * 512 * 2; } },
          [=](const f32x4 (&acc)[2][2][4][2], int pm, int pn, int wr, int wc, int fr, int fq) {
              if (pn < 8) epi_bf16<0>(acc, OUTB + (size_t)(pn & 1) * T_ * 1024 + (size_t)pm * 256 * 1024 + (pn >> 1) * 256, 1024, wr, wc, fr, fq);
              else epi_bf16<0>(acc, RC + (size_t)pm * 256 * 2048 + (pn - 8) * 256, 2048, wr, wc, fr, fq); }, vb); }
    PH_END
    PH_BEGIN(4)
    phase_mlstm(p, shm, vb);
    PH_END
    PH_BEGIN(5)
    { const char* A = (const char*)U; const char* B = (const char*)(ws + WS_WT_ZO);
      gemm_phase<true>(lds, 256, 16, 1024, 1024, 1024,
          [=](int pm, int pn, const char*& a, const char*& b) { a = A + (size_t)pm * 256 * 1024 * 2; b = B + (size_t)pn * 256 * 1024 * 2; },
          [=](const f32x4 (&acc)[2][2][4][2], int pm, int pn, int wr, int wc, int fr, int fq) {
              const int esz = pn < 8 ? 2 : 1;
              unsigned char* Ob = (pn < 8 ? (unsigned char*)RC : (unsigned char*)OUTB) + ((size_t)pm * 256 * 2048 + (pn & 7) * 256) * esz;
              epi_zo(acc, Ob, esz, wr, wc, fr, fq); }, vb); }
    PH_END
    PH_BEGIN(6)
    phase_post(p);
    PH_END
    PH_BEGIN(7)
    { const char* A = (const char*)RA; const char* B = (const char*)(ws + WS_WT_OUT0); const float* X = p.in[0]; float* X1 = p.out; float* SS1 = (float*)(ws + WS_SS1);
      gemm_phase<false>(lds, 256, 4, 2048, 2048, 2048,
          [=](int pm, int pn, const char*& a, const char*& b) { a = A + (size_t)pm * 256 * 2048 * 2; b = B + (size_t)pn * 256 * 2048 * 2; },
          [=](const f32x4 (&acc)[2][2][4][2], int pm, int pn, int wr, int wc, int fr, int fq) {
#pragma unroll
              for (int ai = 0; ai < 2; ++ai)
#pragma unroll
                  for (int m = 0; m < 4; ++m) { const int row = pm * 256 + ai * 128 + wr * 64 + m * 16 + fr; const size_t ro = (size_t)row * 1024 + pn * 256 + wc * 32 + 4 * fq;
                      float ssq = 0.f;
#pragma unroll
                      for (int bj = 0; bj < 2; ++bj)
#pragma unroll
                          for (int n = 0; n < 2; ++n) { const size_t o = ro + bj * 128 + n * 16; const f32x4 v = *(const f32x4*)(X + o) + acc[ai][bj][m][n];
                              u32x2 wv; wv[0] = pk2(v[0], v[1]); wv[1] = pk2(v[2], v[3]); *(u32x2*)(U + o) = wv;
                              ssq += v[0] * v[0] + v[1] * v[1] + v[2] * v[2] + v[3] * v[3]; }
                      ssq += __shfl_xor(ssq, 16); ssq += __shfl_xor(ssq, 32);
                      if (fq == 0) unsafeAtomicAdd(SS1 + row, ssq); } }, vb); }
    PH_END
    PH_BEGIN(9)
    { const char* A = (const char*)U; const char* B = (const char*)(ws + WS_WT_IN1);
      gemm_phase<true>(lds, 256, 12, 1024, 1024, 1024,
          [=](int pm, int pn, const char*& a, const char*& b) { a = A + (size_t)pm * 256 * 1024 * 2; b = B + (size_t)pn * 256 * 1024 * 2; },
          [=](const f32x4 (&acc)[2][2][4][2], int pm, int pn, int wr, int wc, int fr, int fq) {
              const float* ssr = (const float*)(ws + WS_SS1) + pm * 256;
              if (pn < 6) epi_bf16<0>(acc, RA + (size_t)pm * 256 * 1536 + pn * 256, 1536, wr, wc, fr, fq, ssr);
              else epi_bf16<1>(acc, RC + (size_t)pm * 256 * 1536 + (pn - 6) * 256, 1536, wr, wc, fr, fq, ssr); }, vb); }
    PH_END
    PH_BEGIN(10)
    phase_rglru(p, shm);
    PH_END
    { const char* A = (const char*)RB; const char* B = (const char*)(ws + WS_WT_OUT1); bf16_t* X2B = RA; const f32x4* fg = (const f32x4*)p.in[2]; f32x4* O4 = (f32x4*)p.out;
      LAS float* rowss = (LAS float*)(lds + 131072);
      for (int panel = vb; panel < 256; panel += gridDim.x) {
          { const int tid = opq(threadIdx.x); if (tid < 256) rowss[tid] = 0.f; }
          __syncthreads();
          gemm_phase<false>(lds, 256, 4, 1536, 1536, 1536,
              [=](int pm, int pn, const char*& a, const char*& b) { a = A + (size_t)pm * 256 * 1536 * 2; b = B + (size_t)pn * 256 * 1536 * 2; },
              [=](const f32x4 (&acc)[2][2][4][2], int pm, int pn, int wr, int wc, int fr, int fq) {
#pragma unroll
                  for (int ai = 0; ai < 2; ++ai)
#pragma unroll
                      for (int m = 0; m < 4; ++m) { const int rl = ai * 128 + wr * 64 + m * 16 + fr; const size_t ro = (size_t)(pm * 256 + rl) * 1024 + pn * 256 + wc * 32 + 4 * fq;
                          float ssq = 0.f;
#pragma unroll
                          for (int bj = 0; bj < 2; ++bj)
#pragma unroll
                              for (int n = 0; n < 2; ++n) { const size_t o = ro + bj * 128 + n * 16; const u32x2 xb = *(const u32x2*)(U + o);
                                  const f32x4 v = (f32x4){bflo(xb[0]), bfhi(xb[0]), bflo(xb[1]), bfhi(xb[1])} + acc[ai][bj][m][n];
                                  u32x2 wv; wv[0] = pk2(v[0], v[1]); wv[1] = pk2(v[2], v[3]); *(u32x2*)(X2B + o) = wv;
                                  ssq += v[0] * v[0] + v[1] * v[1] + v[2] * v[2] + v[3] * v[3]; }
                          ssq += __shfl_xor(ssq, 16); ssq += __shfl_xor(ssq, 32);
                          if (fq == 0) __hip_atomic_fetch_add((float*)(shm + 131072) + rl, ssq, __ATOMIC_RELAXED, __HIP_MEMORY_SCOPE_WORKGROUP); } }, vb, panel);
          asm volatile("s_waitcnt vmcnt(0)" ::: "memory");
          __syncthreads();
          { const int tid = opq(threadIdx.x);
            for (int idx = tid; idx < 256 * 128; idx += 512) {
                const int row = idx >> 7, c = idx & 127; const size_t go = (size_t)(panel * 256 + row);
                const u32x4 xb = *(const u32x4*)(X2B + go * 1024 + c * 8);
                const float r = __builtin_amdgcn_rsqf(rowss[row] * (1.f / 1024.f) + EPS_);
                float f[8]; unpack8(xb, f);
                const f32x4 g0 = fg[2 * c], g1 = fg[2 * c + 1];
                O4[go * 256 + 2 * c] = (f32x4){f[0], f[1], f[2], f[3]} * r * g0;
                O4[go * 256 + 2 * c + 1] = (f32x4){f[4], f[5], f[6], f[7]} * r * g1; } }
          __syncthreads();
      } }
}

extern "C" void kernel_launch(void* const* d_in, const int* in_sizes, int n_in, void* d_out, int out_size, void* d_ws, size_t ws_size, hipStream_t stream) {
    static int grid_blocks = 0;
    if (!grid_blocks) {
        int dev = 0, cus = 0, per_cu = 0;
        hipGetDevice(&dev);
        hipDeviceGetAttribute(&cus, hipDeviceAttributeMultiprocessorCount, dev);
        hipFuncSetAttribute((const void*)hybrid_fwd, hipFuncAttributeMaxDynamicSharedMemorySize, LDS_BYTES);
        hipOccupancyMaxActiveBlocksPerMultiprocessor(&per_cu, (const void*)hybrid_fwd, 512, LDS_BYTES);
        if (per_cu < 1) { fprintf(stderr, "occupancy query returned %d\n", per_cu); per_cu = 1; }
        grid_blocks = cus * per_cu;
        if (grid_blocks > 256) grid_blocks = 256;
    }
    Params p{};
    for (int i = 0; i < 23; ++i) p.in[i] = (const float*)d_in[i];
    p.out = (float*)d_out; p.ws = (unsigned char*)d_ws; p.rep_mask = REP_MASK;
    void* args[] = {&p};
    hipError_t e = hipLaunchCooperativeKernel((const void*)hybrid_fwd, dim3(grid_blocks), dim3(512), args, LDS_BYTES, stream);
    if (e != hipSuccess) fprintf(stderr, "cooperative launch failed: %s (grid %d)\n", hipGetErrorString(e), grid_blocks);
}
```
